# Optimizing an MI355X kernel written in HIP

```python
import math
import jax, jax.numpy as jnp
from jax import lax
import numpy as np

D_MODEL = 1024
BATCH = 8
SEQ = 8192
DEPTH = 2

HEAD_DIM = 64
FOX_HEADS = 4
FOX_WIDTH = FOX_HEADS * HEAD_DIM
S5_WIDTH = 256
S5_GROUP = 16
S5_GROUPS = S5_WIDTH // S5_GROUP
S5_STATE = 64
MOBA_HEADS = 4
MOBA_WIDTH = MOBA_HEADS * HEAD_DIM
MOBA_BLOCK = 256
MOBA_TOPK = 3
MOBA_Q_CHUNK = 64
MLA_HEADS = 4
MLA_NOPE = 64
MLA_ROPE = 32
MLA_V = 64
MLA_Q_RANK = 384
MLA_KV_RANK = 128
MLA_WIDTH = MLA_HEADS * MLA_V
D_MIX = FOX_WIDTH + S5_WIDTH + MOBA_WIDTH + MLA_WIDTH
Q_BLOCK = 128
ROPE_THETA = 10000.0
EPS = 1e-6
NEG = -1e30
SPLITS = (FOX_WIDTH, FOX_WIDTH, FOX_WIDTH, FOX_WIDTH, FOX_HEADS,
          S5_WIDTH, S5_WIDTH,
          MOBA_WIDTH, MOBA_WIDTH, MOBA_WIDTH, MOBA_WIDTH,
          MLA_Q_RANK, MLA_KV_RANK, MLA_ROPE, MLA_WIDTH)
D_IN = sum(SPLITS)
SPLIT_POINTS = [int(v) for v in np.cumsum(SPLITS)[:-1]]

kernel_name = 'hybrid_fox_s5_moba_mla_trunk'


def rmsnorm(x, g):
    xf = x.astype(jnp.float32)
    y = xf * lax.rsqrt(jnp.mean(xf * xf, axis=-1, keepdims=True) + EPS) * g.astype(jnp.float32)
    return y.astype(x.dtype)


def rope(x, pos):
    d = x.shape[-1]
    half = d // 2
    inv = jnp.power(ROPE_THETA, -jnp.arange(half, dtype=jnp.float32) / half)
    ang = pos.astype(jnp.float32)[:, None] * inv[None, :]
    cos = jnp.cos(ang)[None, :, None, :]
    sin = jnp.sin(ang)[None, :, None, :]
    x1 = x[..., :half].astype(jnp.float32)
    x2 = x[..., half:].astype(jnp.float32)
    return jnp.concatenate([x1 * cos - x2 * sin, x1 * sin + x2 * cos], axis=-1).astype(x.dtype)


def dense_causal_attention(q, k, v, log_f_cum=None):
    Bsz, S, H, Dk = q.shape
    nq = S // Q_BLOCK
    scale = Dk ** -0.5
    kpos = jnp.arange(S)
    qb = q.reshape(Bsz, nq, Q_BLOCK, H, Dk).swapaxes(0, 1)
    xs = (jnp.arange(nq), qb)
    if log_f_cum is not None:
        cum_k = log_f_cum.astype(jnp.float32).transpose(0, 2, 1)
        xs = xs + (cum_k.reshape(Bsz, H, nq, Q_BLOCK).transpose(2, 0, 1, 3),)

    def one_block(args):
        i, q_blk = args[0], args[1]
        s = jnp.einsum('bqhd,bkhd->bhqk', q_blk, k).astype(jnp.float32) * scale
        if log_f_cum is not None:
            s = s + args[2][..., None] - cum_k[:, :, None, :]
        qpos = i * Q_BLOCK + jnp.arange(Q_BLOCK)
        s = jnp.where(kpos[None, :] <= qpos[:, None], s, NEG)
        p = jax.nn.softmax(s, axis=-1)
        return jnp.einsum('bhqk,bkhd->bqhd', p.astype(v.dtype), v)

    out = lax.map(one_block, xs)
    return out.swapaxes(0, 1).reshape(Bsz, S, H, v.shape[-1])


def moba_attention(q, k, v):
    Bsz, S, H, D = q.shape
    nblk = -(-S // MOBA_BLOCK)
    pad = nblk * MOBA_BLOCK - S
    padw = ((0, 0), (0, pad), (0, 0), (0, 0))
    kb = jnp.pad(k, padw).reshape(Bsz, nblk, MOBA_BLOCK, H, D).transpose(0, 3, 1, 2, 4)
    vb = jnp.pad(v, padw).reshape(Bsz, nblk, MOBA_BLOCK, H, D).transpose(0, 3, 1, 2, 4)
    kmean = kb.astype(jnp.float32).mean(axis=3)
    topk = min(MOBA_TOPK, nblk)
    nchunk = S // MOBA_Q_CHUNK
    scale = D ** -0.5
    qc = q.reshape(Bsz, nchunk, MOBA_Q_CHUNK, H, D).transpose(1, 0, 3, 2, 4)
    blk_ids = jnp.arange(nblk)
    gather = jax.vmap(jax.vmap(lambda t, idx: t[idx]))

    def one_chunk(args):
        c, q_c = args
        start = c * MOBA_Q_CHUNK
        qpos = start + jnp.arange(MOBA_Q_CHUNK)
        blk = start // MOBA_BLOCK
        gate = jnp.einsum('bhqd,bhnd->bhqn', q_c.astype(jnp.float32), kmean)
        gate = jnp.where(blk_ids < blk, gate, -jnp.inf)
        _, sel = lax.top_k(gate, topk)
        valid = sel < blk
        k_sel = gather(kb, sel)
        v_sel = gather(vb, sel)
        s_sel = jnp.einsum('bhqd,bhqnkd->bhqnk', q_c, k_sel).astype(jnp.float32) * scale
        s_sel = jnp.where(valid[..., None], s_sel, NEG).reshape(Bsz, H, MOBA_Q_CHUNK, topk * MOBA_BLOCK)
        k_own = lax.dynamic_slice_in_dim(kb, blk, 1, axis=2)[:, :, 0]
        v_own = lax.dynamic_slice_in_dim(vb, blk, 1, axis=2)[:, :, 0]
        s_own = jnp.einsum('bhqd,bhkd->bhqk', q_c, k_own).astype(jnp.float32) * scale
        kpos_own = blk * MOBA_BLOCK + jnp.arange(MOBA_BLOCK)
        s_own = jnp.where(kpos_own[None, :] <= qpos[:, None], s_own, NEG)
        p = jax.nn.softmax(jnp.concatenate([s_sel, s_own], axis=-1), axis=-1).astype(v.dtype)
        p_sel = p[..., :topk * MOBA_BLOCK].reshape(Bsz, H, MOBA_Q_CHUNK, topk, MOBA_BLOCK)
        p_own = p[..., topk * MOBA_BLOCK:]
        return (jnp.einsum('bhqnk,bhqnkd->bhqd', p_sel, v_sel)
                + jnp.einsum('bhqk,bhkd->bhqd', p_own, v_own))

    out = lax.map(one_chunk, (jnp.arange(nchunk), qc))
    return out.transpose(1, 0, 3, 2, 4).reshape(Bsz, S, H, D)


def s5_mixer(u, a_re, a_im, log_dt, b_re, b_im, c_re, c_im, d, glu_w, glu_b):
    f32 = jnp.float32
    Bsz, S, _ = u.shape
    ug = u.astype(f32).reshape(Bsz, S, S5_GROUPS, S5_GROUP)
    lam = lax.complex(a_re.astype(f32), a_im.astype(f32))
    dt = jnp.exp(log_dt.astype(f32))[:, None]
    lam_bar = jnp.exp(lam * dt)
    b = lax.complex(b_re.astype(f32), b_im.astype(f32))
    b_bar = ((lam_bar - 1.0) / lam)[..., None] * b
    bu = jnp.einsum('bsgc,gpc->bsgp', ug.astype(jnp.complex64), b_bar)
    lam_seq = jnp.broadcast_to(lam_bar, bu.shape)

    def combine(left, right):
        a_l, x_l = left
        a_r, x_r = right
        return a_r * a_l, a_r * x_l + x_r

    _, states = lax.associative_scan(combine, (lam_seq, bu), axis=1)
    c = lax.complex(c_re.astype(f32), c_im.astype(f32))
    y = jnp.einsum('bsgp,gcp->bsgc', states, c).real.reshape(Bsz, S, S5_WIDTH)
    y = y + d.astype(f32) * u.astype(f32)
    y = jax.nn.gelu(y)
    y = y * jax.nn.sigmoid(y @ glu_w.astype(f32) + glu_b.astype(f32))
    return y.astype(u.dtype)


def hybrid_layer(x, pos, norm_g, w_in, fox_fb, s5_a_re, s5_a_im, s5_log_dt, s5_b_re, s5_b_im,
                 s5_c_re, s5_c_im, s5_d, s5_glu_w, s5_glu_b, mla_q_norm, mla_w_uq, mla_kv_norm,
                 mla_w_ukv, w_out):
    Bsz, S, _ = x.shape
    h = rmsnorm(x, norm_g)
    z = h @ w_in
    (fq, fk, fv, fg, ff, su, sg, mq, mk, mv, mg, cq, ckv, kr, lg) = jnp.split(z, SPLIT_POINTS, axis=-1)
    heads = lambda t, n: t.reshape(Bsz, S, n, -1)

    log_f = jax.nn.log_sigmoid(ff.astype(jnp.float32) + fox_fb.astype(jnp.float32))
    cum = jnp.cumsum(log_f, axis=1)
    a_out = dense_causal_attention(heads(fq, FOX_HEADS), heads(fk, FOX_HEADS), heads(fv, FOX_HEADS), cum)
    a_out = a_out.reshape(Bsz, S, FOX_WIDTH) * jax.nn.silu(fg)

    b_out = s5_mixer(su, s5_a_re, s5_a_im, s5_log_dt, s5_b_re, s5_b_im, s5_c_re, s5_c_im,
                     s5_d, s5_glu_w, s5_glu_b) * jax.nn.silu(sg)

    c_out = moba_attention(rope(heads(mq, MOBA_HEADS), pos), rope(heads(mk, MOBA_HEADS), pos),
                           heads(mv, MOBA_HEADS))
    c_out = c_out.reshape(Bsz, S, MOBA_WIDTH) * jax.nn.silu(mg)

    qf = (rmsnorm(cq, mla_q_norm) @ mla_w_uq).reshape(Bsz, S, MLA_HEADS, MLA_NOPE + MLA_ROPE)
    q_nope, q_r = qf[..., :MLA_NOPE], rope(qf[..., MLA_NOPE:], pos)
    kv = (rmsnorm(ckv, mla_kv_norm) @ mla_w_ukv).reshape(Bsz, S, MLA_HEADS, MLA_NOPE + MLA_V)
    k_nope, v_d = kv[..., :MLA_NOPE], kv[..., MLA_NOPE:]
    k_r = jnp.broadcast_to(rope(kr.reshape(Bsz, S, 1, MLA_ROPE), pos), (Bsz, S, MLA_HEADS, MLA_ROPE))
    d_out = dense_causal_attention(jnp.concatenate([q_nope, q_r], axis=-1),
                                   jnp.concatenate([k_nope, k_r], axis=-1), v_d)
    d_out = d_out.reshape(Bsz, S, MLA_WIDTH) * jax.nn.silu(lg)

    mix = jnp.concatenate([a_out, b_out, c_out, d_out], axis=-1)
    return x + (mix @ w_out).astype(x.dtype)


def setup_inputs(seed: int = 0) -> dict:
    key = jax.random.key(seed)
    ks = jax.random.split(key, 20)
    f32 = jnp.float32
    nrm = lambda k, shape, s: s * jax.random.normal(k, shape, f32)
    L, G, P, C = DEPTH, S5_GROUPS, S5_STATE, S5_GROUP
    x = jax.random.normal(ks[0], (BATCH, SEQ, D_MODEL), f32)
    norm_g = 1.0 + nrm(ks[1], (L, D_MODEL), 0.02)
    w_in = nrm(ks[2], (L, D_MODEL, D_IN), D_MODEL ** -0.5)
    fox_fb = 3.0 + nrm(ks[3], (L, FOX_HEADS), 0.1)
    s5_a_re = -0.5 + nrm(ks[4], (L, G, P), 0.01)
    s5_a_im = jnp.pi * jnp.arange(P, dtype=f32) + nrm(ks[5], (L, G, P), 0.01)
    s5_log_dt = jax.random.uniform(ks[6], (L, G), f32, math.log(1e-3), math.log(1e-1))
    s5_b_re = nrm(ks[7], (L, G, P, C), (2 * C) ** -0.5)
    s5_b_im = nrm(ks[8], (L, G, P, C), (2 * C) ** -0.5)
    s5_c_re = nrm(ks[9], (L, G, C, P), (2 * P) ** -0.5)
    s5_c_im = nrm(ks[10], (L, G, C, P), (2 * P) ** -0.5)
    s5_d = nrm(ks[11], (L, S5_WIDTH), 1.0)
    s5_glu_w = nrm(ks[12], (L, S5_WIDTH, S5_WIDTH), S5_WIDTH ** -0.5)
    s5_glu_b = nrm(ks[13], (L, S5_WIDTH), 0.02)
    mla_q_norm = 1.0 + nrm(ks[14], (L, MLA_Q_RANK), 0.02)
    mla_w_uq = nrm(ks[15], (L, MLA_Q_RANK, MLA_HEADS * (MLA_NOPE + MLA_ROPE)), MLA_Q_RANK ** -0.5)
    mla_kv_norm = 1.0 + nrm(ks[16], (L, MLA_KV_RANK), 0.02)
    mla_w_ukv = nrm(ks[17], (L, MLA_KV_RANK, MLA_HEADS * (MLA_NOPE + MLA_V)), MLA_KV_RANK ** -0.5)
    w_out = nrm(ks[18], (L, D_MIX, D_MODEL), D_MIX ** -0.5)
    final_g = 1.0 + nrm(ks[19], (D_MODEL,), 0.02)
    return {'x': x, 'norm_g': norm_g, 'w_in': w_in, 'fox_fb': fox_fb,
            's5_a_re': s5_a_re, 's5_a_im': s5_a_im, 's5_log_dt': s5_log_dt,
            's5_b_re': s5_b_re, 's5_b_im': s5_b_im, 's5_c_re': s5_c_re, 's5_c_im': s5_c_im,
            's5_d': s5_d, 's5_glu_w': s5_glu_w, 's5_glu_b': s5_glu_b,
            'mla_q_norm': mla_q_norm, 'mla_w_uq': mla_w_uq, 'mla_kv_norm': mla_kv_norm,
            'mla_w_ukv': mla_w_ukv, 'w_out': w_out, 'final_g': final_g}


def reference(x, norm_g, w_in, fox_fb, s5_a_re, s5_a_im, s5_log_dt, s5_b_re, s5_b_im, s5_c_re,
              s5_c_im, s5_d, s5_glu_w, s5_glu_b, mla_q_norm, mla_w_uq, mla_kv_norm, mla_w_ukv,
              w_out, final_g):
    pos = jnp.arange(x.shape[1])
    for l in range(DEPTH):
        x = hybrid_layer(x, pos, norm_g[l], w_in[l], fox_fb[l], s5_a_re[l], s5_a_im[l], s5_log_dt[l],
                         s5_b_re[l], s5_b_im[l], s5_c_re[l], s5_c_im[l], s5_d[l], s5_glu_w[l],
                         s5_glu_b[l], mla_q_norm[l], mla_w_uq[l], mla_kv_norm[l], mla_w_ukv[l], w_out[l])
    return rmsnorm(x, final_g)
```

```cpp
#include <hip/hip_runtime.h>
#include <hip/hip_cooperative_groups.h>
#include <cstdint>
#include <cstdio>
namespace cg = cooperative_groups;

#define LAS __attribute__((address_space(3)))
typedef unsigned short bf16_t;
typedef short bf16x8 __attribute__((ext_vector_type(8)));
typedef float f32x4 __attribute__((ext_vector_type(4)));
typedef float f32x2 __attribute__((ext_vector_type(2)));
typedef float f32x16 __attribute__((ext_vector_type(16)));
typedef unsigned u32x4 __attribute__((ext_vector_type(4)));
typedef unsigned u32x2 __attribute__((ext_vector_type(2)));

constexpr int NB = 8, SEQ = 8192, DMODEL = 1024, MROWS = NB * SEQ, ZP = 3584, NLAYER = 2;
constexpr int NTHREADS = 512;
constexpr float LOG2E = 1.4426950408889634f;
constexpr float C2A = 0.125f * 1.4426950408889634f;
constexpr float C2M = 0.10206207261596577f * 1.4426950408889634f;
constexpr int Z_FQ = 0, Z_FK = 320, Z_FV = 640, Z_FG = 896, Z_SU = 1152, Z_SG = 1408, Z_MQ = 1664, Z_MK = 1920, Z_MV = 2176, Z_MG = 2432,
              Z_CQ = 2688, Z_CKV = 3072, Z_KR = 3200, Z_LG = 3232, Z_FF = 3488;
constexpr size_t MiB = 1u << 20;
constexpr size_t WS_CTL = 0;
constexpr size_t WS_W1T = 1 * MiB;
constexpr size_t WS_W2T = 16 * MiB;
constexpr size_t WS_WUQT = 20 * MiB;
constexpr size_t WS_WUKVT = 21 * MiB;
constexpr size_t WS_GLUT = 21 * MiB + 512 * 1024;
constexpr size_t WS_TABM = 22 * MiB;
constexpr size_t WS_TABL = 24 * MiB;
constexpr size_t WS_S5LAM = 25 * MiB;
constexpr size_t WS_S5BB = 25 * MiB + 64 * 1024;
constexpr size_t WS_S5CB = 25 * MiB + 256 * 1024;
constexpr size_t WS_KMH = 26 * MiB;
constexpr size_t WS_KML = 26 * MiB + 128 * 1024;
constexpr size_t WS_RSQ = 27 * MiB;
constexpr size_t WS_RSKV = 27 * MiB + 256 * 1024;
constexpr size_t WS_E = 28 * MiB;
constexpr size_t WS_XIN = 44 * MiB;
constexpr size_t WS_XN = 64 * MiB;
constexpr size_t WS_Z = 192 * MiB;
constexpr size_t WS_QM = 640 * MiB;
constexpr size_t WS_KM = 688 * MiB;
constexpr size_t WS_VM = 736 * MiB;
constexpr size_t WS_PO = 768 * MiB;
constexpr size_t WS_PML = 896 * MiB;
constexpr size_t WS_LIST = 904 * MiB;
constexpr size_t WS_FST = 512 * 1024;
constexpr size_t WS_CUM = 60 * MiB;
constexpr size_t WS_END = 936 * MiB;

constexpr int LDS_BYTES = 150 * 1024;
#ifndef PM
#define PM 0xffff
#endif
#define DBG_REP4 1
#define DBG_REP1 1
#define DBG_ZERO 0

struct Params {
    const float* in[20];
    float* out;
    unsigned char* ws;
};

__device__ __forceinline__ int fresh_tid_(int wave_s) { unsigned m = ~0u; asm volatile("" : "+s"(m)); int t = (wave_s << 6) | (int)__builtin_amdgcn_mbcnt_hi(m, __builtin_amdgcn_mbcnt_lo(m, 0u)); asm volatile("" : "+v"(t)); return t; }
#define fresh_tid() fresh_tid_(wave_s)
__device__ __forceinline__ void gbar(unsigned* bw, unsigned n, unsigned G, unsigned bxu, int tid) {
    asm volatile("s_waitcnt vmcnt(0)" ::: "memory");
    __syncthreads();
    if (tid == 0) {
        __builtin_amdgcn_fence(__ATOMIC_RELEASE, "agent");
        asm volatile("s_waitcnt vmcnt(0)" ::: "memory");
        asm volatile("" : "+s"(G), "+s"(bxu), "+s"(bw));
        const bool two = (G & 7u) == 0u; const unsigned ng = two ? 8u : 1u, gsz = two ? (G >> 3) : G, g = two ? (bxu & 7u) : 0u;
        unsigned* cg_ = bw + 64u * (1u + g); unsigned* top = bw + 64u * 10u; unsigned* gen = bw + 64u * 11u;
        const unsigned old = __hip_atomic_fetch_add(cg_, 1u, __ATOMIC_RELAXED, __HIP_MEMORY_SCOPE_AGENT);
        if (old + 1u == n * gsz) {
            const unsigned old2 = __hip_atomic_fetch_add(top, 1u, __ATOMIC_RELAXED, __HIP_MEMORY_SCOPE_AGENT);
            if (old2 + 1u == n * ng) __hip_atomic_store(gen, n, __ATOMIC_RELAXED, __HIP_MEMORY_SCOPE_AGENT);
        }
        while (__hip_atomic_load(gen, __ATOMIC_RELAXED, __HIP_MEMORY_SCOPE_AGENT) < n) __builtin_amdgcn_s_sleep(1);
        __builtin_amdgcn_fence(__ATOMIC_ACQUIRE, "agent");
        asm volatile("s_waitcnt vmcnt(0)" ::: "memory");
    }
    __syncthreads();
}
typedef __bf16 bf16x2_hw __attribute__((ext_vector_type(2)));
__device__ __forceinline__ unsigned f2bf(float f) { float __attribute__((ext_vector_type(2))) v = {f, 0.f}; bf16x2_hw b = __builtin_convertvector(v, bf16x2_hw); return __builtin_bit_cast(unsigned, b) & 0xffffu; }
__device__ __forceinline__ float bf2f(unsigned b) { return __builtin_bit_cast(float, (b & 0xffffu) << 16); }
typedef __bf16 bf16x2_t __attribute__((ext_vector_type(2)));
__device__ __forceinline__ unsigned cvt_pk_bf16(float lo, float hi) { f32x2 v = {lo, hi}; bf16x2_t b = __builtin_convertvector(v, bf16x2_t); return __builtin_bit_cast(unsigned, b); }
__device__ __forceinline__ unsigned pk2(float lo, float hi) { return cvt_pk_bf16(lo, hi); }
__device__ __forceinline__ int crow(int r, int hi) { return (r & 3) + 8 * (r >> 2) + 4 * hi; }
__device__ __forceinline__ float bperm_f(int srclane, float v) { return __builtin_bit_cast(float, __builtin_amdgcn_ds_bpermute(srclane << 2, __builtin_bit_cast(int, v))); }
__device__ __forceinline__ float wave_sum(float v, int lane) {
#pragma unroll
    for (int o = 1; o < 64; o <<= 1) v += bperm_f(lane ^ o, v);
    return v;
}
__device__ __forceinline__ float other_half_f(float v, int hi) { auto rr = __builtin_amdgcn_permlane32_swap(__builtin_bit_cast(unsigned, v), __builtin_bit_cast(unsigned, v), false, false); return __builtin_bit_cast(float, hi ? rr[0] : rr[1]); }
__device__ __forceinline__ int other_half_i(int v, int hi) { auto rr = __builtin_amdgcn_permlane32_swap((unsigned)v, (unsigned)v, false, false); return (int)(hi ? rr[0] : rr[1]); }
__device__ __forceinline__ float sigmoidf_(float x) { return __builtin_amdgcn_rcpf(1.f + __expf(-x)); }
__device__ __forceinline__ float siluf_(float x) { return x * __builtin_amdgcn_rcpf(1.f + __expf(-x)); }
__device__ __forceinline__ void sincos_acc(float ang, float& s, float& c) {
    const double a = (double)ang;
    const double q = rint(a * 0.63661977236758134308);
    const double y = fma(-q, 1.57079632679489661923, a) - q * 6.123233995736766e-17;
    const double y2 = y * y;
    double sp = -1.0 / 6227020800.0; sp = sp * y2 + 1.0 / 39916800.0; sp = sp * y2 - 1.0 / 362880.0; sp = sp * y2 + 1.0 / 5040.0; sp = sp * y2 - 1.0 / 120.0; sp = sp * y2 + 1.0 / 6.0;
    const double sy = y - y * y2 * sp;
    double cp = 1.0 / 479001600.0; cp = cp * y2 - 1.0 / 3628800.0; cp = cp * y2 + 1.0 / 40320.0; cp = cp * y2 - 1.0 / 720.0; cp = cp * y2 + 1.0 / 24.0; cp = cp * y2 - 0.5;
    const double cy = 1.0 + y2 * cp;
    const int qi = ((int)q) & 3;
    const double ss = (qi == 0) ? sy : (qi == 1) ? cy : (qi == 2) ? -sy : -cy;
    const double cc = (qi == 0) ? cy : (qi == 1) ? -sy : (qi == 2) ? -cy : sy;
    s = (float)ss; c = (float)cc;
}

__device__ __forceinline__ size_t kt_off(int row, int h, int chunk) { const int b = row >> 13, t = row & (SEQ - 1); return ((((size_t)(b * 4 + h) * 128 + (t >> 6)) * 12 + chunk) * 64 + (t & 63)) * 8; }
__device__ __forceinline__ size_t vt_off(int row, int h, int d) { const int b = row >> 13, t = row & (SEQ - 1); const int w = (d >> 5) * 4 + ((t >> 4) & 3), ln = (t & 15) * 4 + ((d >> 3) & 3);
    return ((((size_t)(b * 4 + h) * 128 + (t >> 6)) * 8 + w) * 64 + ln) * 8 + (d & 7); }
namespace pg8 {
constexpr int BM = 256, BK = 64, HALF = 128, HTB = HALF * BK * 2, STAGE_BYTES = 8 * HTB, NXCD = 8, WGM = 8;
__device__ __forceinline__ int lds_byte(int r, int c) { const int st = (r >> 4) * 2 + (c >> 5), rr = r & 15, cc = c & 31, ob = rr * 64 + cc * 2; return st * 1024 + (ob ^ (((ob >> 9) & 1) << 5)); }
__device__ __forceinline__ void stage_rc(int b, int& R, int& C) { const int st = b / 1024, sb = b % 1024, swz = sb ^ (((sb >> 9) & 1) << 5); R = (st >> 1) * 16 + swz / 64; C = (st & 1) * 32 + (swz % 64) / 2; }
__device__ __forceinline__ int perm32(int rho) { const int n = rho >> 4, i = rho & 15; return 8 * (i >> 2) + 4 * n + (i & 3); }
struct Unit { int pm, pn; };
struct Gemm { const bf16_t* A; int lda; const bf16_t* Bt; int M, N, K; };
struct StaticOrder {
    int nM, nN, nwg, G, c; bool panel;
    __device__ void init(int M, int N, int G_, int c_, bool panel_ = false) { nM = M / BM; nN = N / BM; nwg = nM * nN; G = G_; c = c_; panel = panel_; }
    __device__ bool next(int i, Unit& u) const {
        if (panel) { const int p = c + (i / nN) * G; if (p >= nM) return false; u.pm = p; u.pn = (i + c) % nN; return true; }
        const long L = (long)i * G + c; if (L >= nwg) return false;
        int wgid = (int)L; { const int q = nwg / NXCD, r = nwg % NXCD, xcd = wgid % NXCD, off = wgid / NXCD; wgid = (xcd < r ? xcd * (q + 1) : r * (q + 1) + (xcd - r) * q) + off; }
        const int nig = WGM * nN, gid = wgid / nig, fm = gid * WGM, gsz = (nM - fm) < WGM ? (nM - fm) : WGM;
        u.pm = fm + ((wgid % nig) % gsz); u.pn = (wgid % nig) / gsz; return true;
    }
};
template <class Epi, bool ALIGN_EPI>
__device__ __forceinline__ void gemm_phase(int tid, LAS unsigned char* lds, const Gemm g, const StaticOrder& S, const Epi& E) {
    const int wid = __builtin_amdgcn_readfirstlane(tid >> 6), lane = tid & 63, wr = wid >> 2, wc = wid & 3, fr = lane & 15, fq = lane >> 4;
    const int K = g.K, nt = K / BK, lda = g.lda;
    unsigned voffA[2], voffB[2];
#pragma unroll
    for (int i = 0; i < 2; ++i) { int R, C; stage_rc(tid * 16 + i * 8192, R, C); const int Rb = Epi::PERM ? ((R & ~31) + perm32(R & 31)) : R;
        voffA[i] = (unsigned)(R * lda + C) * 2u; voffB[i] = (unsigned)(Rb * K + C) * 2u; }
    const unsigned kstep = (unsigned)(BK * 2);
    const unsigned hstepA = (unsigned)HALF * lda * 2u, hstepB = (unsigned)HALF * K * 2u;
    const unsigned tstepA = 2u * hstepA, tstepB = 2u * hstepB;
    const unsigned ldsw = (unsigned)wid * 1024u;
    const int aoff = lds_byte(wr * 64 + fr, fq * 8), boff = lds_byte(wc * 32 + fr, fq * 8);
    const char* const baseA = (const char*)g.A; const char* const baseB = (const char*)g.Bt;
#define PG8_SA(b, h) (((b) * 2 + (h)) * HTB)
#define PG8_SB(b, h) ((4 + (b) * 2 + (h)) * HTB)
#define PG8_STAGE(bufoff, gbase, uoff, voff) do { _Pragma("unroll") for (int _i = 0; _i < 2; ++_i) \
        __builtin_amdgcn_global_load_lds((const unsigned*)((gbase) + (size_t)(unsigned)((uoff) + (voff)[_i])), (LAS unsigned*)(lds + (bufoff) + ldsw + _i * 8192), 16, 0, 0); } while (0)
#define PG8_LDA(dst, b, h) do { _Pragma("unroll") for (int m = 0; m < 4; ++m) _Pragma("unroll") for (int k = 0; k < 2; ++k) dst[m][k] = *(const LAS bf16x8*)(lds + PG8_SA(b, h) + aoff + m * 2048 + k * 1024); } while (0)
#define PG8_LDB(dst, b, h) do { _Pragma("unroll") for (int n = 0; n < 2; ++n) _Pragma("unroll") for (int k = 0; k < 2; ++k) dst[n][k] = *(const LAS bf16x8*)(lds + PG8_SB(b, h) + boff + n * 2048 + k * 1024); } while (0)
#define PG8_MMA(ai, bj, At, Bt) do { __builtin_amdgcn_s_setprio(1); _Pragma("unroll") for (int m = 0; m < 4; ++m) _Pragma("unroll") for (int n = 0; n < 2; ++n) _Pragma("unroll") for (int k = 0; k < 2; ++k) \
        acc[ai][bj][m][n] = __builtin_amdgcn_mfma_f32_16x16x32_bf16(Bt[n][k], At[m][k], acc[ai][bj][m][n], 0, 0, 0); __builtin_amdgcn_s_setprio(0); } while (0)
#define PG8_WAIT_V(n) asm volatile("s_waitcnt vmcnt(" #n ")" ::: "memory")
#define PG8_WAIT_L(n) asm volatile("s_waitcnt lgkmcnt(" #n ")" ::: "memory")
#define PG8_BAR __builtin_amdgcn_s_barrier()
#define PG8_SCHED __builtin_amdgcn_sched_barrier(0)
    Unit cur, nxt; int ui = 0;
    if (!S.next(0, cur)) return;
    f32x4 acc[2][2][4][2];
#pragma unroll
    for (int a = 0; a < 2; ++a)
#pragma unroll
        for (int b = 0; b < 2; ++b)
#pragma unroll
            for (int m = 0; m < 4; ++m)
#pragma unroll
                for (int n = 0; n < 2; ++n) acc[a][b][m][n] = (f32x4){0.f, 0.f, 0.f, 0.f};
    bf16x8 At[4][2], B0[2][2], B1[2][2];
    unsigned cA = (unsigned)cur.pm * tstepA, cB = (unsigned)cur.pn * tstepB;
    PG8_STAGE(PG8_SB(0, 0), baseB, cB, voffB); PG8_STAGE(PG8_SB(0, 1), baseB, cB + hstepB, voffB); PG8_STAGE(PG8_SA(0, 0), baseA, cA, voffA); PG8_STAGE(PG8_SA(0, 1), baseA, cA + hstepA, voffA);
    if (wr == 1) PG8_BAR;
    PG8_WAIT_V(2); PG8_BAR;
    PG8_STAGE(PG8_SB(1, 0), baseB, cB + kstep, voffB); PG8_STAGE(PG8_SA(1, 0), baseA, cA + kstep, voffA); PG8_STAGE(PG8_SB(1, 1), baseB, cB + hstepB + kstep, voffB);
    PG8_WAIT_V(6); PG8_BAR;
    for (;;) {
        const bool has_next = S.next(ui + 1, nxt);
        const unsigned nA = has_next ? (unsigned)nxt.pm * tstepA : cA; const unsigned nB = has_next ? (unsigned)nxt.pn * tstepB : cB;
        for (int t = 0; t < nt; t += 2) {
            const bool last = (t == nt - 2);
            const unsigned a1 = cA + (unsigned)(t + 1) * kstep;
            const unsigned a2 = last ? nA : cA + (unsigned)(t + 2) * kstep; const unsigned b2 = last ? nB : cB + (unsigned)(t + 2) * kstep;
            const unsigned a3 = a2 + kstep; const unsigned b3 = b2 + kstep;
            PG8_LDB(B0, 0, 0); PG8_LDB(B1, 0, 1); PG8_SCHED; PG8_LDA(At, 0, 0); PG8_STAGE(PG8_SA(1, 1), baseA, a1 + hstepA, voffA);
            PG8_WAIT_V(8); PG8_WAIT_L(0); PG8_BAR; PG8_MMA(0, 0, At, B0); PG8_MMA(0, 1, At, B1); PG8_BAR; PG8_SCHED;
            PG8_LDA(At, 0, 1); PG8_STAGE(PG8_SB(0, 0), baseB, b2, voffB); PG8_STAGE(PG8_SB(0, 1), baseB, b2 + hstepB, voffB); PG8_STAGE(PG8_SA(0, 0), baseA, a2, voffA);
            PG8_WAIT_V(8); PG8_WAIT_L(0); PG8_BAR; PG8_MMA(1, 0, At, B0); PG8_MMA(1, 1, At, B1); PG8_BAR; PG8_SCHED;
            PG8_LDB(B0, 1, 0); PG8_LDB(B1, 1, 1); PG8_SCHED; PG8_LDA(At, 1, 0); PG8_STAGE(PG8_SA(0, 1), baseA, a2 + hstepA, voffA);
            PG8_WAIT_V(8); PG8_WAIT_L(0); PG8_BAR; PG8_MMA(0, 0, At, B0); PG8_MMA(0, 1, At, B1); PG8_BAR; PG8_SCHED;
            PG8_LDA(At, 1, 1); PG8_STAGE(PG8_SB(1, 0), baseB, b3, voffB); PG8_STAGE(PG8_SB(1, 1), baseB, b3 + hstepB, voffB); PG8_STAGE(PG8_SA(1, 0), baseA, a3, voffA);
            PG8_WAIT_V(8); PG8_WAIT_L(0); PG8_BAR; PG8_MMA(1, 0, At, B0); PG8_MMA(1, 1, At, B1); PG8_BAR; PG8_SCHED;
        }
        if constexpr (ALIGN_EPI) { if (wr == 0) PG8_BAR; }
        E(acc, cur, wr, wc, fr, fq);
        if (!has_next) break;
#pragma unroll
        for (int a = 0; a < 2; ++a)
#pragma unroll
            for (int b = 0; b < 2; ++b)
#pragma unroll
                for (int m = 0; m < 4; ++m)
#pragma unroll
                    for (int n = 0; n < 2; ++n) acc[a][b][m][n] = (f32x4){0.f, 0.f, 0.f, 0.f};
        cur = nxt; cA = nA; cB = nB; ++ui;
        if constexpr (ALIGN_EPI) { if (wr == 1) PG8_BAR; }
    }
    PG8_WAIT_V(0);
    if constexpr (!ALIGN_EPI) { if (wr == 0) PG8_BAR; }
    PG8_BAR;
#undef PG8_SA
#undef PG8_SB
#undef PG8_STAGE
#undef PG8_LDA
#undef PG8_LDB
#undef PG8_MMA
#undef PG8_WAIT_V
#undef PG8_WAIT_L
#undef PG8_BAR
#undef PG8_SCHED
}
struct EpiZ {
    static constexpr bool PERM = true;
    bf16_t* O; int ldc;
    __device__ __forceinline__ void operator()(const f32x4 (&acc)[2][2][4][2], const Unit& u, int wr, int wc, int fr, int fq) const {
        const int row0 = u.pm * BM + wr * 64 + fr; const int col0 = u.pn * BM + wc * 32 + 8 * fq;
#pragma unroll
        for (int ai = 0; ai < 2; ++ai)
#pragma unroll
            for (int m = 0; m < 4; ++m) { bf16_t* rowp = O + (size_t)(row0 + ai * HALF + m * 16) * ldc + col0;
#pragma unroll
                for (int bj = 0; bj < 2; ++bj) { const f32x4 v0 = acc[ai][bj][m][0], v1 = acc[ai][bj][m][1];
                    u32x4 w; w.x = cvt_pk_bf16(v0[0], v0[1]); w.y = cvt_pk_bf16(v0[2], v0[3]); w.z = cvt_pk_bf16(v1[0], v1[1]); w.w = cvt_pk_bf16(v1[2], v1[3]);
                    *(u32x4*)(rowp + bj * HALF) = w; } }
    }
};
struct EpiMlaQ {
    static constexpr bool PERM = true;
    bf16_t* O; const float* rs;
    __device__ __forceinline__ void operator()(const f32x4 (&acc)[2][2][4][2], const Unit& u, int wr, int wc, int fr, int fq) const {
        const int row0 = u.pm * BM + wr * 64 + fr; const int col0 = u.pn * BM + wc * 32 + 8 * fq;
#pragma unroll
        for (int ai = 0; ai < 2; ++ai)
#pragma unroll
            for (int m = 0; m < 4; ++m) { asm volatile("" ::: "memory"); const int row = row0 + ai * HALF + m * 16; const float sc = rs[row] * C2M; bf16_t* rowp = O + (size_t)row * 384 + col0;
#pragma unroll
                for (int bj = 0; bj < 2; ++bj) { if (col0 + bj * HALF < 384) { const f32x4 v0 = acc[ai][bj][m][0] * sc, v1 = acc[ai][bj][m][1] * sc;
                    u32x4 w; w.x = cvt_pk_bf16(v0[0], v0[1]); w.y = cvt_pk_bf16(v0[2], v0[3]); w.z = cvt_pk_bf16(v1[0], v1[1]); w.w = cvt_pk_bf16(v1[2], v1[3]);
                    *(u32x4*)(rowp + bj * HALF) = w; } } }
    }
};
struct EpiMlaKV {
    static constexpr bool PERM = true;
    bf16_t* KMp; bf16_t* VMp; const float* rs;
    __device__ __forceinline__ void operator()(const f32x4 (&acc)[2][2][4][2], const Unit& u, int wr, int wc, int fr, int fq) const {
        const int row0 = u.pm * BM + wr * 64 + fr; const int colt = wc * 32 + 8 * fq;
#pragma unroll
        for (int ai = 0; ai < 2; ++ai)
#pragma unroll
            for (int m = 0; m < 4; ++m) { asm volatile("" ::: "memory"); const int row = row0 + ai * HALF + m * 16; const float sc = rs[row];
#pragma unroll
                for (int bj = 0; bj < 2; ++bj) { const int c = colt + bj * HALF; const f32x4 v0 = acc[ai][bj][m][0] * sc, v1 = acc[ai][bj][m][1] * sc;
                    u32x4 w; w.x = cvt_pk_bf16(v0[0], v0[1]); w.y = cvt_pk_bf16(v0[2], v0[3]); w.z = cvt_pk_bf16(v1[0], v1[1]); w.w = cvt_pk_bf16(v1[2], v1[3]);
                    bf16_t* dst = (u.pn == 0) ? (KMp + kt_off(row, c >> 6, (c & 63) >> 3)) : (VMp + vt_off(row, c >> 6, c & 63));
                    *(u32x4*)dst = w; } }
    }
};
struct EpiRes {
    static constexpr bool PERM = false;
    const float* base; float* out;
    __device__ __forceinline__ void operator()(const f32x4 (&acc)[2][2][4][2], const Unit& u, int wr, int wc, int fr, int fq) const {
        const int row0 = u.pm * BM + wr * 64 + fr; const int col0 = u.pn * BM + wc * 32 + 4 * fq;
#pragma unroll
        for (int ai = 0; ai < 2; ++ai)
#pragma unroll
            for (int m = 0; m < 4; ++m) { const size_t off = (size_t)(row0 + ai * HALF + m * 16) * DMODEL + col0;
#pragma unroll
                for (int bj = 0; bj < 2; ++bj)
#pragma unroll
                    for (int n = 0; n < 2; ++n) { const f32x4 bs = *(const f32x4*)(base + off + bj * HALF + n * 16); *(f32x4*)(out + off + bj * HALF + n * 16) = bs + acc[ai][bj][m][n]; } }
    }
};
}

__device__ __forceinline__ int colmap(int kind, int n, float& sc) {
    sc = 1.f;
    if (kind == 1) return n;
    if (kind == 2) return n < 384 ? n : -1;
    if (kind == 3) { const int nn = n & 255, h = nn >> 6, d = nn & 63; return h * 128 + d + ((n >= 256) ? 64 : 0); }
    if (n < 320) { const int h = n / 80, d = n % 80; sc = C2A; return d < 64 ? h * 64 + d : -1; }
    if (n < 640) { const int nn = n - 320, h = nn / 80, d = nn % 80; return d < 64 ? 256 + h * 64 + d : -1; }
    if (n < 896) return 512 + (n - 640);
    if (n < 1152) return 768 + (n - 896);
    if (n < 1408) return 1028 + (n - 1152);
    if (n < 1664) return 1284 + (n - 1408);
    if (n < 1920) { sc = C2A; return 1540 + (n - 1664); }
    if (n < 2176) return 1796 + (n - 1920);
    if (n < 2432) return 2052 + (n - 2176);
    if (n < 2688) return 2308 + (n - 2432);
    if (n < 3072) return 2564 + (n - 2688);
    if (n < 3200) return 2948 + (n - 3072);
    if (n < 3232) return 3076 + (n - 3200);
    if (n < 3488) return 3108 + (n - 3232);
    if (n < 3492) return 1024 + (n - 3488);
    return -1;
}
__device__ __forceinline__ void tconv_item(int tid, const float* W, int ldw, int kind, const float* rs, bf16_t* O, int K, int k0, int n0, LAS float* scr) {
#pragma unroll
    for (int i = 0; i < 8; ++i) { const int idx = tid + 512 * i, kk = idx >> 6, nn = idx & 63; float sc; const int src = colmap(kind, n0 + nn, sc);
        float v = 0.f; if (src >= 0) { v = W[(size_t)(k0 + kk) * ldw + src] * sc; if (rs) v *= rs[k0 + kk]; }
        scr[kk * 65 + nn] = v; }
    __syncthreads();
    { const int nn = tid >> 3, c = tid & 7; const LAS float* s = scr + (8 * c) * 65 + nn;
      u32x4 o; o.x = pk2(s[0], s[65]); o.y = pk2(s[2 * 65], s[3 * 65]); o.z = pk2(s[4 * 65], s[5 * 65]); o.w = pk2(s[6 * 65], s[7 * 65]);
      *(u32x4*)(O + (size_t)(n0 + nn) * K + k0 + 8 * c) = o; }
    __syncthreads();
}
__device__ __forceinline__ void rms_row2(const float* xa, const float* xb, bf16_t* oa, bf16_t* obb, float* fa, float* fb, const float* g, int lane) {
    const f32x4* ra = (const f32x4*)xa + lane; const f32x4* rb = (const f32x4*)xb + lane;
    f32x4 va[4], vb[4]; float sa = 0.f, sb = 0.f;
#pragma unroll
    for (int j = 0; j < 4; ++j) { va[j] = ra[64 * j]; vb[j] = rb[64 * j]; }
#pragma unroll
    for (int j = 0; j < 4; ++j) { sa += (va[j].x * va[j].x + va[j].y * va[j].y) + (va[j].z * va[j].z + va[j].w * va[j].w); sb += (vb[j].x * vb[j].x + vb[j].y * vb[j].y) + (vb[j].z * vb[j].z + vb[j].w * vb[j].w); }
#pragma unroll
    for (int o = 1; o < 64; o <<= 1) { sa += bperm_f(lane ^ o, sa); sb += bperm_f(lane ^ o, sb); }
    const float rsa = 1.f / sqrtf(sa * (1.f / DMODEL) + 1e-6f), rsb = 1.f / sqrtf(sb * (1.f / DMODEL) + 1e-6f);
    if (oa) {
        u32x2* o8a = (u32x2*)oa + lane; u32x2* o8b = (u32x2*)obb + lane;
#pragma unroll
        for (int j = 0; j < 4; ++j) { u32x2 w; w.x = pk2(va[j].x * rsa, va[j].y * rsa); w.y = pk2(va[j].z * rsa, va[j].w * rsa); o8a[64 * j] = w;
            u32x2 w2; w2.x = pk2(vb[j].x * rsb, vb[j].y * rsb); w2.y = pk2(vb[j].z * rsb, vb[j].w * rsb); o8b[64 * j] = w2; }
    } else {
        const f32x4* gr = (const f32x4*)g + lane; f32x4* o1 = (f32x4*)fa + lane; f32x4* o2 = (f32x4*)fb + lane;
#pragma unroll
        for (int j = 0; j < 4; ++j) { const f32x4 gg = gr[64 * j]; o1[64 * j] = va[j] * rsa * gg; o2[64 * j] = vb[j] * rsb * gg; }
    }
}
__device__ __forceinline__ void res_rms_row2(const float* xa, const float* xb, const bf16_t* da, const bf16_t* db, float* keepa, float* keepb, bf16_t* na, bf16_t* nb,
                                             float* fina, float* finb, const float* g, int lane) {
    const f32x4* ra = (const f32x4*)xa + lane; const f32x4* rb = (const f32x4*)xb + lane;
    const u32x2* qa = (const u32x2*)da + lane; const u32x2* qb = (const u32x2*)db + lane;
    f32x4 va[4], vb[4]; u32x2 ea[4], eb[4]; float sa = 0.f, sb = 0.f;
#pragma unroll
    for (int j = 0; j < 4; ++j) { va[j] = ra[64 * j]; vb[j] = rb[64 * j]; ea[j] = qa[64 * j]; eb[j] = qb[64 * j]; }
#pragma unroll
    for (int j = 0; j < 4; ++j) {
        va[j].x += bf2f(ea[j].x); va[j].y += bf2f(ea[j].x >> 16); va[j].z += bf2f(ea[j].y); va[j].w += bf2f(ea[j].y >> 16);
        vb[j].x += bf2f(eb[j].x); vb[j].y += bf2f(eb[j].x >> 16); vb[j].z += bf2f(eb[j].y); vb[j].w += bf2f(eb[j].y >> 16);
        sa += (va[j].x * va[j].x + va[j].y * va[j].y) + (va[j].z * va[j].z + va[j].w * va[j].w); sb += (vb[j].x * vb[j].x + vb[j].y * vb[j].y) + (vb[j].z * vb[j].z + vb[j].w * vb[j].w); }
#pragma unroll
    for (int o = 1; o < 64; o <<= 1) { sa += bperm_f(lane ^ o, sa); sb += bperm_f(lane ^ o, sb); }
    const float rsa = 1.f / sqrtf(sa * (1.f / DMODEL) + 1e-6f), rsb = 1.f / sqrtf(sb * (1.f / DMODEL) + 1e-6f);
    if (keepa) {
        f32x4* k1 = (f32x4*)keepa + lane; f32x4* k2 = (f32x4*)keepb + lane; u32x2* o8a = (u32x2*)na + lane; u32x2* o8b = (u32x2*)nb + lane;
#pragma unroll
        for (int j = 0; j < 4; ++j) { k1[64 * j] = va[j]; k2[64 * j] = vb[j];
            u32x2 w; w.x = pk2(va[j].x * rsa, va[j].y * rsa); w.y = pk2(va[j].z * rsa, va[j].w * rsa); o8a[64 * j] = w;
            u32x2 w2; w2.x = pk2(vb[j].x * rsb, vb[j].y * rsb); w2.y = pk2(vb[j].z * rsb, vb[j].w * rsb); o8b[64 * j] = w2; }
    } else {
        const f32x4* gr = (const f32x4*)g + lane; f32x4* o1 = (f32x4*)fina + lane; f32x4* o2 = (f32x4*)finb + lane;
#pragma unroll
        for (int j = 0; j < 4; ++j) { const f32x4 gg = gr[64 * j]; o1[64 * j] = va[j] * rsa * gg; o2[64 * j] = vb[j] * rsb * gg; }
    }
}
__device__ __forceinline__ void rms_row(const float* xrow, bf16_t* ob, float* of, const float* g, int lane) {
    const f32x4* xr = (const f32x4*)xrow + lane;
    f32x4 v[4]; float s = 0.f;
#pragma unroll
    for (int j = 0; j < 4; ++j) { v[j] = xr[64 * j]; s += (v[j].x * v[j].x + v[j].y * v[j].y) + (v[j].z * v[j].z + v[j].w * v[j].w); }
    const float rstd = 1.f / sqrtf(wave_sum(s, lane) * (1.f / DMODEL) + 1e-6f);
    if (ob) {
        u32x2* o8 = (u32x2*)ob + lane;
#pragma unroll
        for (int j = 0; j < 4; ++j) { u32x2 w; w.x = pk2(v[j].x * rstd, v[j].y * rstd); w.y = pk2(v[j].z * rstd, v[j].w * rstd); o8[64 * j] = w; }
    } else {
        const f32x4* gr = (const f32x4*)g + lane; f32x4* o = (f32x4*)of + lane;
#pragma unroll
        for (int j = 0; j < 4; ++j) { const f32x4 gg = gr[64 * j]; o[64 * j] = v[j] * rstd * gg; }
    }
}

template <bool FINAL>
__device__ __forceinline__ void s5_item(int tid, const Params& P, int l, int b, int c, LAS unsigned char* lds) {
    const int lane = tid & 63, wid = __builtin_amdgcn_readfirstlane(tid >> 6), r32 = lane & 31, hi = lane >> 5;
    unsigned char* ws = P.ws;
    const bf16_t* z = (const bf16_t*)(ws + WS_Z);
    const float* lamt = (const float*)(ws + WS_S5LAM);
    const bf16_t* Bb = (const bf16_t*)(ws + WS_S5BB);
    const bf16_t* Cb = (const bf16_t*)(ws + WS_S5CB);
    float* E = (float*)(ws + WS_E); const float* XIN = (const float*)(ws + WS_XIN);
    LAS float* scr = (LAS float*)(lds + wid * 16384);
    LAS bf16_t* Xs = (LAS bf16_t*)scr;
    LAS bf16_t* Ys = (LAS bf16_t*)(lds + 131072);
    const int row0 = b * SEQ + c * 32;
    bf16x8 ua[2], bb[2][4]; f32x4 lm[2]; float xr0[2], xi0[2];
#pragma unroll
    for (int gi = 0; gi < 2; ++gi) {
        const int g = wid * 2 + gi;
        ua[gi] = *(const bf16x8*)(z + (size_t)(row0 + r32) * ZP + Z_SU + g * 16 + 8 * hi);
#pragma unroll
        for (int nt = 0; nt < 4; ++nt) bb[gi][nt] = *(const bf16x8*)(Bb + ((size_t)(l * 16 + g) * 128 + nt * 32 + r32) * 16 + 8 * hi);
        lm[gi] = *(const f32x4*)(lamt + ((size_t)(l * 16 + g) * 64 + lane) * 4);
        const size_t sidx = ((size_t)(b * 256 + c) * 16 + g) * 128 + lane;
        xr0[gi] = 0.f; xi0[gi] = 0.f;
        if (FINAL) { xr0[gi] = XIN[sidx]; xi0[gi] = XIN[sidx + 64]; }
    }
    __builtin_amdgcn_sched_barrier(0);
#pragma unroll
    for (int gi = 0; gi < 2; ++gi) {
        const int g = wid * 2 + gi;
        bf16x8 cbv[8]; float dcv = 0.f, uv[16];
        if (FINAL) {
#pragma unroll
            for (int ks = 0; ks < 8; ++ks) cbv[ks] = *(const bf16x8*)(Cb + ((size_t)(l * 16 + g) * 32 + r32) * 128 + 16 * ks + 8 * hi);
            const int chp = g * 16 + (r32 & 15); dcv = P.in[11][l * 256 + chp];
#pragma unroll
            for (int r = 0; r < 16; ++r) uv[r] = bf2f(z[(size_t)(row0 + crow(r, hi)) * ZP + Z_SU + chp]); }
        f32x16 bu[4];
#pragma unroll
        for (int nt = 0; nt < 4; ++nt) { f32x16 zz = {}; bu[nt] = __builtin_amdgcn_mfma_f32_32x32x16_bf16(ua[gi], bb[gi][nt], zz, 0, 0, 0); }
#pragma unroll
        for (int nt = 0; nt < 4; ++nt)
#pragma unroll
            for (int r = 0; r < 16; ++r) scr[crow(r, hi) * 128 + nt * 32 + r32] = bu[nt][r];
        asm volatile("s_waitcnt lgkmcnt(0)" ::: "memory");
        const int p = lane;
        const size_t sidx = ((size_t)(b * 256 + c) * 16 + g) * 128 + p;
        float xr = xr0[gi], xi = xi0[gi];
        float br[32], bi[32];
#pragma unroll
        for (int t = 0; t < 32; ++t) { br[t] = scr[t * 128 + p]; bi[t] = scr[t * 128 + 64 + p]; }
        asm volatile("s_waitcnt lgkmcnt(0)" ::: "memory");
#pragma unroll
        for (int t = 0; t < 32; ++t) {
            const float nr = lm[gi].x * xr - lm[gi].y * xi + br[t], ni = lm[gi].x * xi + lm[gi].y * xr + bi[t]; xr = nr; xi = ni;
            if (FINAL) { const unsigned w = cvt_pk_bf16(xr, xi); Xs[t * 136 + p] = (bf16_t)(w & 0xffffu); Xs[t * 136 + 64 + p] = (bf16_t)(w >> 16); }
        }
        if (!FINAL) { E[sidx] = xr; E[sidx + 64] = xi; }
        asm volatile("" ::: "memory");
        if (FINAL) {
            f32x16 y = {};
#pragma unroll
            for (int ks = 0; ks < 8; ++ks) { const bf16x8 xa = *(const LAS bf16x8*)(Xs + r32 * 136 + 16 * ks + 8 * hi);
                y = __builtin_amdgcn_mfma_f32_32x32x16_bf16(xa, cbv[ks], y, 0, 0, 0); }
            if (r32 < 16) { const int ch = g * 16 + r32;
#pragma unroll
                for (int r = 0; r < 16; ++r) { const int t = crow(r, hi);
                    float v = y[r] + dcv * uv[r]; const float a = 0.7978845608028654f * (v + 0.044715f * v * v * v); const float th = 1.f - 2.f * __builtin_amdgcn_rcpf(__expf(2.f * a) + 1.f); v = 0.5f * v * (1.f + th);
                    Ys[t * 264 + ch] = (bf16_t)f2bf(v); } }
        }
        asm volatile("s_waitcnt lgkmcnt(0)" ::: "memory");
    }
    if (FINAL) {
        const bf16_t* GLUt = (const bf16_t*)(ws + WS_GLUT) + (size_t)l * 65536;
        bf16_t* mix = (bf16_t*)(ws + WS_XN);
        const int n = 32 * wid + r32; const float bias = P.in[13][l * 256 + n];
        bf16x8 gbv[16]; float sgv[16];
#pragma unroll
        for (int ks = 0; ks < 16; ++ks) gbv[ks] = *(const bf16x8*)(GLUt + (size_t)(32 * wid + r32) * 256 + 16 * ks + 8 * hi);
#pragma unroll
        for (int r = 0; r < 16; ++r) sgv[r] = bf2f(z[(size_t)(row0 + crow(r, hi)) * ZP + Z_SG + n]);
        __syncthreads();
        f32x16 acc = {};
#pragma unroll
        for (int ks = 0; ks < 16; ++ks) { const bf16x8 ya = *(const LAS bf16x8*)(Ys + r32 * 264 + 16 * ks + 8 * hi);
            acc = __builtin_amdgcn_mfma_f32_32x32x16_bf16(ya, gbv[ks], acc, 0, 0, 0); }
#pragma unroll
        for (int r = 0; r < 16; ++r) { const int t = crow(r, hi); const float yv = bf2f(Ys[t * 264 + n]); const float lin = acc[r] + bias;
            const float sg = sgv[r];
            mix[(size_t)(row0 + t) * DMODEL + 256 + n] = ((DBG_ZERO >> 1) & 1) ? (bf16_t)0 : (bf16_t)f2bf(yv * sigmoidf_(lin) * siluf_(sg)); }
        __syncthreads();
    }
}

typedef short s16x4 __attribute__((ext_vector_type(4)));
__device__ __forceinline__ s16x4 vtr(const LAS unsigned char* p) { return __builtin_bit_cast(s16x4, __builtin_amdgcn_ds_read_tr16_b64_v4i16((LAS s16x4*)p)); }
__device__ __forceinline__ void glds16(const void* gsrc, unsigned lds_dst) { unsigned keep;
    asm volatile("s_mov_b32 %0, m0\n\ts_mov_b32 m0, %2\n\ts_nop 0\n\tglobal_load_lds_dwordx4 %1, off\n\ts_mov_b32 m0, %0" : "=&s"(keep) : "v"(gsrc), "s"(lds_dst) : "memory"); }
struct AttnPtrs { const bf16_t* Q; int qp; const bf16_t* K; int kp; const bf16_t* V; int vp; const bf16_t* G; bf16_t* O; };
__device__ __forceinline__ void moba_select(int tid, const Params& P, int b, int h, int qb) {
    const int lane = tid & 63, wid = __builtin_amdgcn_readfirstlane(tid >> 6), r32 = lane & 31, hi = lane >> 5;
    const int pos = qb * 256 + wid * 32 + r32;
    const bf16_t* Q = (const bf16_t*)(P.ws + WS_Z) + ((size_t)b * SEQ + pos) * ZP + Z_MQ + h * 64;
    bf16x8 qr[4];
#pragma unroll
    for (int d0 = 0; d0 < 4; ++d0) qr[d0] = *(const bf16x8*)(Q + 16 * d0 + 8 * hi);
    { const float* tab = (const float*)(P.ws + WS_TABM) + (size_t)pos * 64;
#pragma unroll
      for (int d0 = 0; d0 < 2; ++d0) { const int i0 = 16 * d0 + 8 * hi; bf16x8 a = qr[d0], c2 = qr[d0 + 2];
#pragma unroll
        for (int e = 0; e < 8; ++e) { const float cs = tab[i0 + e], sn = tab[32 + i0 + e]; const float x1 = bf2f((unsigned short)a[e]), x2 = bf2f((unsigned short)c2[e]);
            a[e] = (short)f2bf(x1 * cs - x2 * sn); c2[e] = (short)f2bf(x1 * sn + x2 * cs); }
        qr[d0] = a; qr[d0 + 2] = c2; } }
    unsigned sel = 0u;
    {
        const bf16_t* kmh = (const bf16_t*)(P.ws + WS_KMH) + (size_t)((b * 4 + h) * 32 + r32) * 64;
        const bf16_t* kml = (const bf16_t*)(P.ws + WS_KML) + (size_t)((b * 4 + h) * 32 + r32) * 64;
        f32x16 gt = {};
#pragma unroll
        for (int d0 = 0; d0 < 4; ++d0) { const bf16x8 ah = *(const bf16x8*)(kmh + 16 * d0 + 8 * hi), al = *(const bf16x8*)(kml + 16 * d0 + 8 * hi);
            gt = __builtin_amdgcn_mfma_f32_32x32x16_bf16(ah, qr[d0], gt, 0, 0, 0); gt = __builtin_amdgcn_mfma_f32_32x32x16_bf16(al, qr[d0], gt, 0, 0, 0); }
#pragma unroll
        for (int r = 0; r < 16; ++r) if (crow(r, hi) >= qb) gt[r] = -INFINITY;
        sel = 0u;
#pragma unroll 1
        for (int round = 0; round < 3; ++round) {
            float bv = -INFINITY; int bi = 99;
#pragma unroll
            for (int r = 0; r < 16; ++r) if (gt[r] > bv) { bv = gt[r]; bi = crow(r, hi); }
            const float ov = other_half_f(bv, hi); const int oi = other_half_i(bi, hi);
            const bool mine = (bv > ov) || (bv == ov && bi < oi);
            const float wv = mine ? bv : ov; const int wi = mine ? bi : oi;
            if (wv > -INFINITY) sel |= 1u << wi;
#pragma unroll
            for (int r = 0; r < 16; ++r) if (crow(r, hi) == wi) gt[r] = -INFINITY;
        }
    }

    unsigned* cnt = (unsigned*)(P.ws + WS_CTL) + 1024 + (b * 4 + h) * 32;
    unsigned* list = (unsigned*)(P.ws + WS_LIST) + (size_t)(b * 4 + h) * 32 * 8192;
    unsigned mycount = 0u;
    for (int n = 0; n < qb; ++n) { const unsigned long long bal = __builtin_amdgcn_ballot_w64(((sel >> n) & 1u) && hi == 0);
        if (lane == n) mycount = (unsigned)__builtin_popcountll(bal); }
    unsigned mybase = 0u;
    if (lane < qb && mycount != 0u) mybase = atomicAdd(cnt + lane, mycount);
    for (int n = 0; n < qb; ++n) {
        const bool mine = ((sel >> n) & 1u) && hi == 0;
        const unsigned long long bal = __builtin_amdgcn_ballot_w64(mine);
        if (bal == 0ull) continue;
        const unsigned base = (unsigned)__builtin_amdgcn_readlane((int)mybase, n);
        if (mine) { const unsigned off = (unsigned)__builtin_popcountll(bal & ((1ull << lane) - 1ull)); const unsigned rk = (unsigned)__builtin_popcount(sel & ((1u << n) - 1u));
            list[(size_t)n * 8192 + base + off] = (unsigned)pos | (rk << 16); }
    }
}
__device__ __forceinline__ void swap_pair(unsigned& a, unsigned& b) { auto rr = __builtin_amdgcn_permlane32_swap(a, b, false, false); a = rr[0]; b = rr[1]; }
struct MobaCtx { const unsigned* list; int cnt, n, ubase; };
template <int ND, int MODE>
__device__ __forceinline__ void attn_unit(int tid, const AttnPtrs& A, const Params& P, int b, int h, int qb, LAS unsigned char* lds, const MobaCtx mc) {
    constexpr int KBYTES = 64 * ND * 16 * 2;
    const int lane = tid & 63, wid = __builtin_amdgcn_readfirstlane(tid >> 6), r32 = lane & 31, hi = lane >> 5;
    const size_t rowb = (size_t)b * SEQ;
    const bool gathered = (MODE == 1) && (mc.list != nullptr);
    int ub = gathered ? mc.ubase : 0;
#pragma unroll 1
    for (;;) {
    int pos = qb * 256 + wid * 32 + r32;
    int rank = 3; bool qvalid = true;
    if (gathered) { const int e = ub + wid * 32 + r32; qvalid = e < mc.cnt; const unsigned ent = mc.list[qvalid ? e : (mc.cnt - 1)]; pos = (int)(ent & 0xffffu); rank = (int)(ent >> 16); }
    const size_t qrow = rowb + pos;
    bf16x8 qr[ND];
#pragma unroll
    for (int d0 = 0; d0 < ND; ++d0) qr[d0] = *(const bf16x8*)(A.Q + qrow * A.qp + 16 * d0 + 8 * hi);
    if (MODE == 1) {
        const float* tab = (const float*)(P.ws + WS_TABM) + (size_t)pos * 64;
#pragma unroll
        for (int d0 = 0; d0 < 2; ++d0) { const int i0 = 16 * d0 + 8 * hi; bf16x8 a = qr[d0], c2 = qr[d0 + 2];
#pragma unroll
            for (int e = 0; e < 8; ++e) { const float cs = tab[i0 + e], sn = tab[32 + i0 + e]; const float x1 = bf2f((unsigned short)a[e]), x2 = bf2f((unsigned short)c2[e]);
                a[e] = (short)f2bf(x1 * cs - x2 * sn); c2[e] = (short)f2bf(x1 * sn + x2 * cs); }
            qr[d0] = a; qr[d0 + 2] = c2; }
    }
    if (MODE == 2) {
        const float* tab = (const float*)(P.ws + WS_TABL) + (size_t)pos * 32; const int i0 = 8 * hi; bf16x8 a = qr[4], c2 = qr[5];
#pragma unroll
        for (int e = 0; e < 8; ++e) { const float cs = tab[i0 + e], sn = tab[16 + i0 + e]; const float x1 = bf2f((unsigned short)a[e]), x2 = bf2f((unsigned short)c2[e]);
            a[e] = (short)f2bf(x1 * cs - x2 * sn); c2[e] = (short)f2bf(x1 * sn + x2 * cs); }
        qr[4] = a; qr[5] = c2;
    }
    constexpr int KSLOT = ND * 2048, VSLOT = 8192;
    const bf16_t* kg = (MODE == 2) ? (const bf16_t*)(P.ws + WS_KM) + ((size_t)(b * 4 + h) * 128 * 12 * 64 + (size_t)wid * 64 + lane) * 8 : A.K + (rowb + lane) * A.kp + 8 * wid;
    const bf16_t* vg = (MODE == 2) ? (const bf16_t*)(P.ws + WS_VM) + (((size_t)(b * 4 + h) * 128 * 8 + wid) * 64 + lane) * 8 : A.V + (rowb + 16 * (wid & 3) + (lane >> 2)) * A.vp + (wid >> 2) * 32 + (lane & 3) * 8;
    const size_t kts = (MODE == 2) ? (size_t)12 * 64 * 8 : (size_t)64 * A.kp, vts = (MODE == 2) ? (size_t)8 * 64 * 8 : (size_t)64 * A.vp, k2o = (MODE == 2) ? (size_t)8 * 64 * 8 : (size_t)64;
    const bool k2 = (wid + 8) < 2 * ND;
    LAS unsigned char* Kb = lds; LAS unsigned char* Vb = lds + 4 * KSLOT;
    const unsigned kdst = (unsigned)(uintptr_t)Kb + wid * 1024, vdst = (unsigned)(uintptr_t)Vb + wid * 1024;
#define DMA_TILE(t_, slot_) do { const size_t adv_ = (size_t)(tile0 + (t_)); \
        glds16(kg + adv_ * kts, (unsigned)__builtin_amdgcn_readfirstlane(kdst + (slot_) * KSLOT)); \
        if (k2) glds16(kg + adv_ * kts + k2o, (unsigned)__builtin_amdgcn_readfirstlane(kdst + (slot_) * KSLOT + 8192)); \
        glds16(vg + adv_ * vts, (unsigned)__builtin_amdgcn_readfirstlane(vdst + (slot_) * VSLOT)); } while (0)
#define WAIT_BAR(N) asm volatile("s_waitcnt vmcnt(" #N ") lgkmcnt(0)\n\ts_barrier" ::: "memory")
    const int tile0 = (MODE == 1) ? (gathered ? 4 * mc.n : 4 * qb) : 0;
    const int NT = (MODE == 1) ? 4 : 4 * (qb + 1);
#define TI(it_) ((MODE == 0) ? (NT - 1 - (it_)) : (it_))
    float qn = 0.f; f32x2 stA = {0.f, 0.f}, stB = {0.f, 0.f}; float mseen = -INFINITY;
    if (MODE == 0) {
#pragma unroll
        for (int d0 = 0; d0 < 4; ++d0)
#pragma unroll
            for (int e = 0; e < 8; ++e) { const float v = bf2f((unsigned short)qr[d0][e]); qn += v * v; }
        qn += other_half_f(qn, hi); qn = sqrtf(qn) * 1.01f;
        const f32x2* st = (const f32x2*)(P.ws + WS_FST) + (size_t)(b * 4 + h) * 128;
        stA = st[lane]; stB = st[lane + 64];
#pragma unroll
        for (int o = 1; o < 64; o <<= 1) { const float ta = bperm_f(lane - o, stA.x), tb = bperm_f(lane - o, stB.x); if (lane >= o) { stA.x = fmaxf(stA.x, ta); stB.x = fmaxf(stB.x, tb); } }
        stB.x = fmaxf(stB.x, __builtin_bit_cast(float, __builtin_amdgcn_readlane(__builtin_bit_cast(int, stA.x), 63)));
    }
    if (!gathered || ub == mc.ubase) {
        DMA_TILE(TI(0), 0); DMA_TILE(TI(1), 1); DMA_TILE(TI(2), 2); if (MODE == 1) DMA_TILE(3, 3);
        WAIT_BAR(0);
    }
    float mrun = 0.f, lrun = 0.f; f32x16 o0 = {}, o1 = {};
    const int qrel = wid * 32 + r32;
    const int vlane = ((lane >> 4) & 1) * 32 + (lane & 3) * 8 + (4 * hi + ((lane & 15) >> 2)) * 64;
    int slot = 0;
    bool stopped = false;
#pragma unroll 1
    for (int it = 0; it < NT; ++it) {
        const int t = TI(it);
        if (MODE != 1 && it + 3 < NT) DMA_TILE(TI(it + 3), (slot + 3) & 3);
        const int trel = (MODE == 1) ? (gathered ? -1 : t) : (t - 4 * qb);
        const bool active = (64 * trel <= 32 * wid + 31);
        if (active) {
            f32x16 p0, p1;
            const LAS unsigned char* kb = Kb + slot * KSLOT + hi * 1024 + r32 * 16;
            bf16x8 kf0[ND], kf1[ND];
#pragma unroll
            for (int d0 = 0; d0 < ND; ++d0) { kf0[d0] = *(const LAS bf16x8*)(kb + d0 * 2048); kf1[d0] = *(const LAS bf16x8*)(kb + d0 * 2048 + 512); }
            { const float cinit = -mrun;
#pragma unroll
            for (int r = 0; r < 16; ++r) { p0[r] = cinit; p1[r] = cinit; } }
            __builtin_amdgcn_sched_barrier(0);
#pragma unroll
            for (int d0 = 0; d0 < ND; ++d0) {
                p0 = __builtin_amdgcn_mfma_f32_32x32x16_bf16(kf0[d0], qr[d0], p0, 0, 0, 0);
                p1 = __builtin_amdgcn_mfma_f32_32x32x16_bf16(kf1[d0], qr[d0], p1, 0, 0, 0);
            }
            __builtin_amdgcn_sched_barrier(0);
            const LAS unsigned char* vb = Vb + slot * VSLOT + vlane;
            s16x4 va0[4], va1[4], vb0[4], vb1[4];
#pragma unroll
            for (int ks = 0; ks < 4; ++ks) { va0[ks] = vtr(vb + ks * 1024); va1[ks] = vtr(vb + ks * 1024 + 512); vb0[ks] = vtr(vb + 4096 + ks * 1024); vb1[ks] = vtr(vb + 4096 + ks * 1024 + 512); }
            __builtin_amdgcn_sched_barrier(0);
            if (trel >= 0) { const int kb0 = 64 * trel + 4 * hi;
#pragma unroll
                for (int r = 0; r < 16; ++r) { const int kv = kb0 + (r & 3) + 8 * (r >> 2); if (kv > qrel) p0[r] = -INFINITY; if (kv + 32 > qrel) p1[r] = -INFINITY; } }
            float ra = fmaxf(fmaxf(p0[0], p0[1]), p1[0]), rb2 = fmaxf(fmaxf(p0[2], p0[3]), p1[1]); ra = fmaxf(fmaxf(ra, p1[2]), p1[3]);
#pragma unroll
            for (int r = 4; r < 16; r += 4) { ra = fmaxf(fmaxf(ra, p0[r]), p0[r + 1]); rb2 = fmaxf(fmaxf(rb2, p0[r + 2]), p0[r + 3]); ra = fmaxf(fmaxf(ra, p1[r]), p1[r + 1]); rb2 = fmaxf(fmaxf(rb2, p1[r + 2]), p1[r + 3]); }
            float rm = fmaxf(ra, rb2);
            rm = fmaxf(rm, other_half_f(rm, hi));
            const bool first = (it == 0);
            if (MODE == 0) mseen = fmaxf(mseen, mrun + rm);
            if (__builtin_amdgcn_ballot_w64(first ? (rm > -1e30f) : (rm > 8.f)) != 0ull) {
                const float dl = first ? ((rm > -1e30f) ? rm : 0.f) : fmaxf(rm, 0.f);
                mrun += dl;
#pragma unroll
                for (int r = 0; r < 16; ++r) { p0[r] -= dl; p1[r] -= dl; }
                const float f = __builtin_amdgcn_exp2f(-dl); lrun *= f;
#pragma unroll
                for (int r = 0; r < 16; ++r) { o0[r] *= f; o1[r] *= f; }
            }
            float ps0 = 0.f, ps1 = 0.f;
#pragma unroll
            for (int r = 0; r < 16; ++r) { p0[r] = __builtin_amdgcn_exp2f(p0[r]); p1[r] = __builtin_amdgcn_exp2f(p1[r]); ps0 += p0[r]; ps1 += p1[r]; }
            lrun += ps0 + ps1;
            u32x4 pw[4];
#pragma unroll
            for (int j = 0; j < 2; ++j) {
                pw[j] = (u32x4){cvt_pk_bf16(p0[8 * j], p0[8 * j + 1]), cvt_pk_bf16(p0[8 * j + 2], p0[8 * j + 3]), cvt_pk_bf16(p0[8 * j + 4], p0[8 * j + 5]), cvt_pk_bf16(p0[8 * j + 6], p0[8 * j + 7])};
                pw[2 + j] = (u32x4){cvt_pk_bf16(p1[8 * j], p1[8 * j + 1]), cvt_pk_bf16(p1[8 * j + 2], p1[8 * j + 3]), cvt_pk_bf16(p1[8 * j + 4], p1[8 * j + 5]), cvt_pk_bf16(p1[8 * j + 6], p1[8 * j + 7])};
            }
            __builtin_amdgcn_sched_barrier(0);
#pragma unroll
            for (int ks = 0; ks < 4; ++ks) {
                const s16x4 a0 = va0[ks], a1 = va1[ks], b0 = vb0[ks], b1 = vb1[ks];
                const bf16x8 v0f = (bf16x8){a0[0], a0[1], a0[2], a0[3], a1[0], a1[1], a1[2], a1[3]}, v1f = (bf16x8){b0[0], b0[1], b0[2], b0[3], b1[0], b1[1], b1[2], b1[3]};
                const bf16x8 pf = __builtin_bit_cast(bf16x8, pw[ks]);
                o0 = __builtin_amdgcn_mfma_f32_32x32x16_bf16(v0f, pf, o0, 0, 0, 0);
                o1 = __builtin_amdgcn_mfma_f32_32x32x16_bf16(v1f, pf, o1, 0, 0, 0);
            }
        }
        LAS int* tf = (LAS int*)(lds + 148 * 1024) + (it & 1) * 8;
        const bool chk = (MODE == 0) && (it + 1 < NT) && (t - 1 < 4 * qb);
        if (chk) { const int tn = t - 1;
            const float kpre = __builtin_bit_cast(float, __builtin_amdgcn_readlane(__builtin_bit_cast(int, tn < 64 ? stA.x : stB.x), tn & 63));
            const float gmx = __builtin_bit_cast(float, __builtin_amdgcn_readlane(__builtin_bit_cast(int, tn < 64 ? stA.y : stB.y), tn & 63));
            const bool need = (qn * kpre + gmx + 0.01f - mseen) >= -40.f;
            const unsigned long long nb = __builtin_amdgcn_ballot_w64(need);
            if (lane == 0) tf[wid] = (nb != 0ull) ? 1 : 0; }
        if (MODE != 1) {
        if (it + 3 < NT) { if (k2) WAIT_BAR(6); else WAIT_BAR(4); }
        else if (it + 2 < NT) { if (k2) WAIT_BAR(3); else WAIT_BAR(2); }
        else WAIT_BAR(0);
        }
        slot = (slot + 1) & 3;
        if (chk) { const int a0 = tf[0] | tf[1] | tf[2] | tf[3] | tf[4] | tf[5] | tf[6] | tf[7];
            if (__builtin_amdgcn_readfirstlane(a0) == 0) { stopped = true; break; } }
    }
    if (stopped) WAIT_BAR(0);
#undef TI
#undef DMA_TILE
#undef WAIT_BAR
    const float ltot = lrun + other_half_f(lrun, hi);
    const float inv = ((DBG_ZERO >> (MODE == 0 ? 0 : MODE == 1 ? 2 : 3)) & 1) ? 0.f : __builtin_amdgcn_rcpf(ltot);
    if (MODE == 1) {
        bf16_t* po = (bf16_t*)(P.ws + WS_PO) + (((qrow * 4 + h) * 4 + rank) * 64);
        if (qvalid && hi == 0) { float* pml = (float*)(P.ws + WS_PML) + ((qrow * 4 + h) * 4 + rank) * 2; pml[0] = mrun; pml[1] = ltot; }
#pragma unroll
        for (int dt = 0; dt < 2; ++dt)
#pragma unroll
            for (int k = 0; k < 2; ++k) { const f32x16& oo = dt ? o1 : o0; const int ra = 8 * k, rb = 8 * k + 4;
                unsigned ax = pk2(oo[ra] * inv, oo[ra + 1] * inv), ay = pk2(oo[ra + 2] * inv, oo[ra + 3] * inv), bx_ = pk2(oo[rb] * inv, oo[rb + 1] * inv), by = pk2(oo[rb + 2] * inv, oo[rb + 3] * inv);
                swap_pair(ax, bx_); swap_pair(ay, by);
                if (qvalid) *(u32x4*)(po + 32 * dt + 16 * k + 8 * hi) = (u32x4){ax, ay, bx_, by}; }
        if (gathered && ub + 256 < mc.cnt) { ub += 256; continue; }
        return;
    }
    const bf16_t* gp = A.G + qrow * ZP; bf16_t* op = A.O + qrow * DMODEL;
#pragma unroll
    for (int dt = 0; dt < 2; ++dt)
#pragma unroll
        for (int k = 0; k < 2; ++k) { const f32x16& oo = dt ? o1 : o0; const int ra = 8 * k, rb = 8 * k + 4;
            const u32x4 gq = *(const u32x4*)(gp + 32 * dt + 16 * k + 8 * hi);
            unsigned gx = gq.x, gy = gq.y, gz = gq.z, gw_ = gq.w;
            swap_pair(gx, gz); swap_pair(gy, gw_);
            unsigned ax = pk2(oo[ra] * inv * siluf_(bf2f(gx)), oo[ra + 1] * inv * siluf_(bf2f(gx >> 16))), ay = pk2(oo[ra + 2] * inv * siluf_(bf2f(gy)), oo[ra + 3] * inv * siluf_(bf2f(gy >> 16)));
            unsigned bx_ = pk2(oo[rb] * inv * siluf_(bf2f(gz)), oo[rb + 1] * inv * siluf_(bf2f(gz >> 16))), by = pk2(oo[rb + 2] * inv * siluf_(bf2f(gw_)), oo[rb + 3] * inv * siluf_(bf2f(gw_ >> 16)));
            swap_pair(ax, bx_); swap_pair(ay, by);
            *(u32x4*)(op + 32 * dt + 16 * k + 8 * hi) = (u32x4){ax, ay, bx_, by}; }
    return;
    }
}

__global__ void __launch_bounds__(NTHREADS, 2) fwd_megakernel(Params P) {
    extern __shared__ __attribute__((aligned(16))) unsigned char lds_raw[];
    LAS unsigned char* lds = (LAS unsigned char*)lds_raw;
    cg::grid_group grid = cg::this_grid();
    const int G = gridDim.x, bx = blockIdx.x;
    unsigned* ctl = (unsigned*)(P.ws + WS_CTL);
    const int wave_s = __builtin_amdgcn_readfirstlane((int)threadIdx.x >> 6);
    if (bx == 0) { ctl[threadIdx.x] = 0u; ctl[threadIdx.x + 512] = 0u; }
    grid.sync();
    unsigned nsync = 0;
#define GSYNC() do { ++nsync; gbar((unsigned*)(P.ws + WS_CTL), nsync, (unsigned)G, (unsigned)bx, fresh_tid()); } while (0)
    const int NGW = G * 8;
#define PHASE_PTRS() unsigned char* ws = P.ws; asm volatile("" : "+s"(ws)); bf16_t* z = (bf16_t*)(ws + WS_Z); bf16_t* xn = (bf16_t*)(ws + WS_XN); (void)z; (void)xn
#define PHASE_IDS() PHASE_PTRS(); const int tid = fresh_tid(), lane = tid & 63, wid = __builtin_amdgcn_readfirstlane(tid >> 6), gw = bx * 8 + wid; (void)lane; (void)gw

    if constexpr ((PM & 1) != 0) {
        PHASE_IDS();
        LAS float* scr = (LAS float*)lds;
        for (int it = bx; it < 2 * 1232; it += G) {
            const int l = it / 1232; int r = it % 1232;
            if (r < 896) { tconv_item(tid, P.in[2] + (size_t)l * 1024 * 3364, 3364, 0, P.in[1] + l * 1024, (bf16_t*)(ws + WS_W1T) + (size_t)l * 3584 * 1024, 1024, (r / 56) * 64, (r % 56) * 64, scr); continue; } r -= 896;
            if (r < 256) { tconv_item(tid, P.in[18] + (size_t)l * 1024 * 1024, 1024, 1, nullptr, (bf16_t*)(ws + WS_W2T) + (size_t)l * 1024 * 1024, 1024, (r / 16) * 64, (r % 16) * 64, scr); continue; } r -= 256;
            if (r < 48) { tconv_item(tid, P.in[15] + (size_t)l * 384 * 384, 384, 2, P.in[14] + l * 384, (bf16_t*)(ws + WS_WUQT) + (size_t)l * 512 * 384, 384, (r / 8) * 64, (r % 8) * 64, scr); continue; } r -= 48;
            if (r < 16) { tconv_item(tid, P.in[17] + (size_t)l * 128 * 512, 512, 3, P.in[16] + l * 128, (bf16_t*)(ws + WS_WUKVT) + (size_t)l * 512 * 128, 128, (r / 8) * 64, (r % 8) * 64, scr); continue; } r -= 16;
            tconv_item(tid, P.in[12] + (size_t)l * 256 * 256, 256, 1, nullptr, (bf16_t*)(ws + WS_GLUT) + (size_t)l * 65536, 256, (r / 4) * 64, (r % 4) * 64, scr);
        }
        float* tabM = (float*)(ws + WS_TABM); float* tabL = (float*)(ws + WS_TABL);
        for (int i = bx * NTHREADS + tid; i < SEQ * 48; i += G * NTHREADS) {
            if (i < SEQ * 32) { const int pos = i >> 5, k = i & 31; const float inv = powf(10000.f, -(float)k / 32.f); float s, c; sincos_acc((float)pos * inv, s, c); tabM[pos * 64 + k] = c; tabM[pos * 64 + 32 + k] = s; }
            else { const int j = i - SEQ * 32, pos = j >> 4, k = j & 15; const float inv = powf(10000.f, -(float)k / 16.f); float s, c; sincos_acc((float)pos * inv, s, c); tabL[pos * 32 + k] = c; tabL[pos * 32 + 16 + k] = s; }
        }
        for (int i = bx * NTHREADS + tid; i < 2 * 16 * 64; i += G * NTHREADS) {
            const int l = i >> 10, g = (i >> 6) & 15, p = i & 63; const int lg = l * 16 + g; const int gp = lg * 64 + p;
            const float ar = P.in[4][gp], ai = P.in[5][gp]; const float dt = expf(P.in[6][lg]);
            const float mag = expf(ar * dt); float s, c; sincos_acc(ai * dt, s, c); const float lr = mag * c, li = mag * s;
            double pr = 1.0, pi = 0.0; for (int k = 0; k < 32; ++k) { const double nr = pr * lr - pi * li, ni = pr * li + pi * lr; pr = nr; pi = ni; }
            float* lt = (float*)(ws + WS_S5LAM) + (size_t)gp * 4; lt[0] = lr; lt[1] = li; lt[2] = (float)pr; lt[3] = (float)pi;
            const float nr_ = lr - 1.f, ni_ = li, den = ar * ar + ai * ai; const float qr_ = (nr_ * ar + ni_ * ai) / den, qi_ = (ni_ * ar - nr_ * ai) / den;
            bf16_t* Bb = (bf16_t*)(ws + WS_S5BB) + (size_t)lg * 128 * 16; bf16_t* Cb = (bf16_t*)(ws + WS_S5CB) + (size_t)lg * 32 * 128;
            for (int ch = 0; ch < 16; ++ch) { const float br = P.in[7][(size_t)gp * 16 + ch], bi = P.in[8][(size_t)gp * 16 + ch];
                Bb[p * 16 + ch] = (bf16_t)f2bf(qr_ * br - qi_ * bi); Bb[(64 + p) * 16 + ch] = (bf16_t)f2bf(qr_ * bi + qi_ * br);
                const float cr = P.in[9][((size_t)lg * 16 + ch) * 64 + p], ci = P.in[10][((size_t)lg * 16 + ch) * 64 + p];
                Cb[ch * 128 + p] = (bf16_t)f2bf(cr); Cb[ch * 128 + 64 + p] = (bf16_t)f2bf(-ci);
                Cb[(16 + ch) * 128 + p] = 0; Cb[(16 + ch) * 128 + 64 + p] = 0; }
        }
        for (int m = gw; m < MROWS; m += 2 * NGW) rms_row2(P.in[0] + (size_t)m * DMODEL, P.in[0] + (size_t)(m + NGW) * DMODEL, xn + (size_t)m * DMODEL, xn + (size_t)(m + NGW) * DMODEL, nullptr, nullptr, nullptr, lane);
    }
    GSYNC();

#pragma unroll 1
    for (int l = 0; l < NLAYER; ++l) {
        if constexpr ((PM & 2) != 0) {
            PHASE_PTRS();
            pg8::Gemm g{xn, DMODEL, (const bf16_t*)(ws + WS_W1T) + (size_t)l * 3584 * 1024, MROWS, ZP, DMODEL};
            pg8::StaticOrder S; S.init(MROWS, ZP, G, bx);
            pg8::EpiZ E{z, ZP};
#pragma unroll 1
            for (int rep = 0; rep < DBG_REP1; ++rep)
            pg8::gemm_phase<pg8::EpiZ, true>(fresh_tid(), lds, g, S, E);
        }
        GSYNC();
        if constexpr ((PM & 4) != 0) {
            PHASE_IDS();
            if (bx == 0) { unsigned* cz = (unsigned*)(ws + WS_CTL) + 1024; cz[tid] = 0u; cz[tid + 512] = 0u; }
            if (bx < 32) {
                const int b = bx >> 2, h = bx & 3; const float fb = P.in[3][l * 4 + h];
                LAS float* sc = (LAS float*)lds;
                float lf[16]; float run = 0.f; const size_t r0 = (size_t)b * SEQ + tid * 16;
#pragma unroll
                for (int i = 0; i < 16; ++i) { const float y = bf2f(z[(r0 + i) * ZP + Z_FF + h]) + fb; const float v = fminf(y, 0.f) - log1pf(expf(-fabsf(y))); run += v; lf[i] = run; }
                float incl = run;
#pragma unroll
                for (int o = 1; o < 64; o <<= 1) { const float t = bperm_f(lane - o, incl); if (lane >= o) incl += t; }
                if (lane == 63) sc[wid] = incl;
                __syncthreads();
                float off = incl - run;
                for (int w = 0; w < wid; ++w) off += sc[w];
                { float* cum = (float*)(ws + WS_CUM) + (size_t)(b * 4 + h) * SEQ + tid * 16;
#pragma unroll
                  for (int i = 0; i < 16; i += 4) *(f32x4*)(cum + i) = (f32x4){off + lf[i], off + lf[i + 1], off + lf[i + 2], off + lf[i + 3]}; }
                __syncthreads();
            }
            for (int it = bx; it < 256; it += G) {
                const int b = it >> 5, n = it & 31;
                LAS bf16_t* ks = (LAS bf16_t*)lds;
                const int pr = tid & 15, h = pr >> 2, c = pr & 3;
#pragma unroll 1
                for (int i = 0; i < 8; ++i) {
                    const int tok = i * 32 + (tid >> 4);
                    const int pos = n * 256 + tok; const size_t row = (size_t)b * SEQ + pos;
                    bf16_t* base = z + row * ZP + Z_MK;
                    const float* tab = (const float*)(ws + WS_TABM) + (size_t)pos * 64;
                    const u32x4 a = *(const u32x4*)(base + h * 64 + 8 * c), bq = *(const u32x4*)(base + h * 64 + 32 + 8 * c);
                    const f32x4 cs0 = *(const f32x4*)(tab + 8 * c), cs1 = *(const f32x4*)(tab + 8 * c + 4), sn0 = *(const f32x4*)(tab + 32 + 8 * c), sn1 = *(const f32x4*)(tab + 32 + 8 * c + 4);
                    const unsigned aw[4] = {a.x, a.y, a.z, a.w}, bw[4] = {bq.x, bq.y, bq.z, bq.w};
                    unsigned o1[4], o2[4];
#pragma unroll
                    for (int j = 0; j < 4; ++j) { const float c0 = (j < 2) ? cs0[2 * j] : cs1[2 * j - 4], c1 = (j < 2) ? cs0[2 * j + 1] : cs1[2 * j - 3];
                        const float s0 = (j < 2) ? sn0[2 * j] : sn1[2 * j - 4], s1 = (j < 2) ? sn0[2 * j + 1] : sn1[2 * j - 3];
                        const float x1a = bf2f(aw[j]), x1b = bf2f(aw[j] >> 16), x2a = bf2f(bw[j]), x2b = bf2f(bw[j] >> 16);
                        o1[j] = pk2(x1a * c0 - x2a * s0, x1b * c1 - x2b * s1); o2[j] = pk2(x1a * s0 + x2a * c0, x1b * s1 + x2b * c1); }
                    const u32x4 w1 = {o1[0], o1[1], o1[2], o1[3]}, w2 = {o2[0], o2[1], o2[2], o2[3]};
                    *(u32x4*)(base + h * 64 + 8 * c) = w1; *(u32x4*)(base + h * 64 + 32 + 8 * c) = w2;
                    *(LAS u32x4*)(ks + tok * 264 + h * 64 + 8 * c) = w1; *(LAS u32x4*)(ks + tok * 264 + h * 64 + 32 + 8 * c) = w2;
                }
                __syncthreads();
                if (tid < 256) { float s = 0.f;
#pragma unroll 8
                    for (int t = 0; t < 256; ++t) s += bf2f(ks[t * 264 + tid]);
                    s *= (1.f / 256.f); const unsigned hh = f2bf(s); const unsigned ll = f2bf(s - bf2f(hh));
                    const size_t o = (size_t)((b * 4 + (tid >> 6)) * 32 + n) * 64 + (tid & 63);
                    ((bf16_t*)(ws + WS_KMH))[o] = (bf16_t)hh; ((bf16_t*)(ws + WS_KML))[o] = (bf16_t)ll; }
                __syncthreads();
            }
            {
                float* rsq = (float*)(ws + WS_RSQ); float* rskv = (float*)(ws + WS_RSKV); bf16_t* KMp = (bf16_t*)(ws + WS_KM);
                for (int m0 = gw; m0 < MROWS; m0 += 4 * NGW) {
                    u32x4 v4[4]; float kx1[4], kx2[4];
#pragma unroll
                    for (int u = 0; u < 4; ++u) { const int m = m0 + u * NGW; const bf16_t* zr = z + (size_t)m * ZP;
                        v4[u] = *(const u32x4*)(zr + Z_CQ + 8 * lane);
                        kx1[u] = bf2f(zr[Z_KR + (lane & 15)]); kx2[u] = bf2f(zr[Z_KR + 16 + (lane & 15)]); }
#pragma unroll
                    for (int u = 0; u < 4; ++u) { const int m = m0 + u * NGW; const u32x4 v = v4[u];
                        float ss = 0.f; { const unsigned w[4] = {v.x, v.y, v.z, v.w};
#pragma unroll
                            for (int j = 0; j < 4; ++j) { const float a = bf2f(w[j]), bq = bf2f(w[j] >> 16); ss += a * a + bq * bq; } }
                        const float sq = wave_sum(lane < 48 ? ss : 0.f, lane), skv = wave_sum(lane >= 48 ? ss : 0.f, lane);
                        if (lane == 0) { rsq[m] = 1.f / sqrtf(sq * (1.f / 384.f) + 1e-6f); rskv[m] = 1.f / sqrtf(skv * (1.f / 128.f) + 1e-6f); }
                        if (lane < 16) { const int pos = m & (SEQ - 1); const float* tab = (const float*)(ws + WS_TABL) + (size_t)pos * 32; const float cs = tab[lane], sn = tab[16 + lane];
                            const float x1 = kx1[u], x2 = kx2[u]; const bf16_t r1 = (bf16_t)f2bf(x1 * cs - x2 * sn), r2 = (bf16_t)f2bf(x1 * sn + x2 * cs);
#pragma unroll
                            for (int h = 0; h < 4; ++h) { KMp[kt_off(m, h, 8 + (lane >> 3)) + (lane & 7)] = r1; KMp[kt_off(m, h, 10 + (lane >> 3)) + (lane & 7)] = r2; } }
                    }
                }
            }
            __syncthreads();
            if (G > 64) { if (bx >= 32) for (int it = bx - 32; it < 2048; it += G - 32) s5_item<false>(fresh_tid(), P, l, it >> 8, it & 255, lds); }
            else for (int it = bx; it < 2048; it += G) s5_item<false>(fresh_tid(), P, l, it >> 8, it & 255, lds);
        }
        GSYNC();
        if constexpr ((PM & 8) != 0) {
            PHASE_IDS();
            { pg8::Gemm g{z + Z_CQ, ZP, (const bf16_t*)(ws + WS_WUQT) + (size_t)l * 512 * 384, MROWS, 512, 384};
              pg8::StaticOrder S; S.init(MROWS, 512, G, bx);
              pg8::EpiMlaQ E{(bf16_t*)(ws + WS_QM), (const float*)(ws + WS_RSQ)};
              pg8::gemm_phase<pg8::EpiMlaQ, true>(fresh_tid(), lds, g, S, E); }
            { pg8::Gemm g{z + Z_CKV, ZP, (const bf16_t*)(ws + WS_WUKVT) + (size_t)l * 512 * 128, MROWS, 512, 128};
              pg8::StaticOrder S; S.init(MROWS, 512, G, bx);
              pg8::EpiMlaKV E{(bf16_t*)(ws + WS_KM), (bf16_t*)(ws + WS_VM), (const float*)(ws + WS_RSKV)};
              pg8::gemm_phase<pg8::EpiMlaKV, true>(fresh_tid(), lds, g, S, E); }
#pragma unroll 1
            for (int it = bx; it < 512; it += G) {
                const int b = it >> 6, tile = 2 * (it & 63) + (tid >> 8), tok = tid & 63, h = (tid >> 6) & 3;
                const int t = tile * 64 + tok; const size_t row = (size_t)b * SEQ + t;
                const float gv = -((const float*)(ws + WS_CUM))[(size_t)(b * 4 + h) * SEQ + t] * LOG2E;
                const bf16_t* kp = z + row * ZP + Z_FK + h * 80; float ssq = 0.f;
#pragma unroll
                for (int c8 = 0; c8 < 8; ++c8) { const u32x4 v = *(const u32x4*)(kp + 8 * c8); const unsigned w[4] = {v.x, v.y, v.z, v.w};
#pragma unroll
                    for (int j = 0; j < 4; ++j) { const float a = bf2f(w[j]), bq = bf2f(w[j] >> 16); ssq += a * a + bq * bq; } }
                const unsigned g1 = f2bf(gv); const float r1 = gv - bf2f(g1); const unsigned g2 = f2bf(r1); const unsigned g3 = f2bf(r1 - bf2f(g2));
                *(u32x2*)(z + row * ZP + Z_FK + h * 80 + 64) = (u32x2){g1 | (g2 << 16), g3};
                { unsigned c1 = 0x3F803F80u, c2 = 0x00003F80u; asm volatile("" : "+v"(c1), "+v"(c2));
                  *(u32x2*)(z + row * ZP + Z_FQ + h * 80 + 64) = (u32x2){c1, c2}; }
#pragma unroll
                for (int o = 1; o < 64; o <<= 1) ssq = fmaxf(ssq, bperm_f(lane ^ o, ssq));
                float* st = (float*)(ws + WS_FST) + ((size_t)(b * 4 + h) * 128 + tile) * 2;
                if (lane == 0) st[0] = sqrtf(ssq) * 1.01f;
                if (lane == 63) st[1] = gv;
            }
#pragma unroll 1
            for (int it = bx; it < 1024; it += G) {
                int qb = it & 31, bh = it >> 5;
                if (G == 256) { const int k = it >> 8; qb = ((bx & 31) + 8 * k) & 31; bh = (bx >> 5) + 8 * k; }
                if (qb > 0) moba_select(fresh_tid(), P, bh >> 2, bh & 3, qb); }
            if (bx < 128 && wid == 0) {
                const int gid = bx * 64 + lane;
                const int b = gid >> 10, gg = (gid >> 6) & 15, p = gid & 63;
                const f32x4 lm = *(const f32x4*)((const float*)(ws + WS_S5LAM) + ((size_t)(l * 16 + gg) * 64 + p) * 4);
                const float* E = (const float*)(ws + WS_E); float* XIN = (float*)(ws + WS_XIN);
                float xr = 0.f, xi = 0.f;
#pragma unroll 1
                for (int c0 = 0; c0 < 256; c0 += 32) {
                    float er[32], ei[32];
#pragma unroll
                    for (int c = 0; c < 32; ++c) { const size_t idx = ((size_t)(b * 256 + c0 + c) * 16 + gg) * 128 + p; er[c] = E[idx]; ei[c] = E[idx + 64]; }
#pragma unroll
                    for (int c = 0; c < 32; ++c) { const size_t idx = ((size_t)(b * 256 + c0 + c) * 16 + gg) * 128 + p; XIN[idx] = xr; XIN[idx + 64] = xi;
                        const float nr = lm.z * xr - lm.w * xi + er[c], ni = lm.z * xi + lm.w * xr + ei[c]; xr = nr; xi = ni; }
                }
            }
        }
        GSYNC();
        if constexpr ((PM & 16) != 0) {
            PHASE_PTRS();
            bf16_t* mix = xn;
            const int xcd = bx & 7, jcu = bx >> 3;
            const MobaCtx mc0{nullptr, 0, 0, 0};
            const int nun = (G == 256) ? 8 : (2048 + G - 1) / G;
#pragma unroll 1
            for (int i = 0; i < nun; ++i) {
                int type, bh, qb;
                if (G == 256) { const int id = 8 * i + xcd; type = id >> 5; bh = id & 31; qb = (i & 1) ? (31 - jcu) : jcu; }
                else { const int it = bx + i * G; if (it >= 2048) break; qb = 31 - it / 64; const int r = it % 64; type = r >> 5; bh = r & 31; }
                const int b = bh >> 2, h = bh & 3;
                if (type == 0) { AttnPtrs A{(const bf16_t*)(ws + WS_QM) + h * 96, 384, (const bf16_t*)(ws + WS_KM) + h * 96, 384, (const bf16_t*)(ws + WS_VM) + h * 64, 256, z + Z_LG + h * 64, mix + 768 + h * 64};
                    attn_unit<6, 2>(fresh_tid(), A, P, b, h, qb, lds, mc0); }
                else { AttnPtrs A{z + Z_FQ + h * 80, ZP, z + Z_FK + h * 80, ZP, z + Z_FV + h * 64, ZP, z + Z_FG + h * 64, mix + h * 64};
                    attn_unit<5, 0>(fresh_tid(), A, P, b, h, qb, lds, mc0); }
            }
            {
                LAS int* qslot = (LAS int*)(lds + 149 * 1024);
                const unsigned* cnts = (const unsigned*)(ws + WS_CTL) + 1024;
#pragma unroll 1
                for (;;) {
                    const int tq = fresh_tid();
                    if (tq == 0) *qslot = (int)atomicAdd((unsigned*)(ws + WS_CTL) + 8 + l, 1u);
                    __syncthreads();
                    const int it = __builtin_amdgcn_readfirstlane(*qslot);
                    __syncthreads();
                    if (it >= 2048) break;
                    if (it < 1024) {
                        const int n = it >> 5, bh = it & 31, b = bh >> 2, h = bh & 3;
                        const int cnt = (int)__builtin_amdgcn_readfirstlane((int)cnts[bh * 32 + n]);
                        AttnPtrs A{z + Z_MQ + h * 64, ZP, z + Z_MK + h * 64, ZP, z + Z_MV + h * 64, ZP, z + Z_MG + h * 64, mix + 512 + h * 64};
                        if (cnt > 0) { const MobaCtx mc{(const unsigned*)(ws + WS_LIST) + (size_t)(bh * 32 + n) * 8192, cnt, n, 0};
                            attn_unit<4, 1>(fresh_tid(), A, P, b, h, 0, lds, mc); }
                    } else {
                        const int j = it - 1024, qb = 31 - (j >> 5), bh = j & 31, b = bh >> 2, h = bh & 3;
                        AttnPtrs A{z + Z_MQ + h * 64, ZP, z + Z_MK + h * 64, ZP, z + Z_MV + h * 64, ZP, z + Z_MG + h * 64, mix + 512 + h * 64};
                        attn_unit<4, 1>(fresh_tid(), A, P, b, h, qb, lds, mc0);
                    }
                }
            }
            __syncthreads();
#pragma unroll 1
            for (int it = bx; it < 2048; it += G) s5_item<true>(fresh_tid(), P, l, it >> 8, it & 255, lds);
        }
        GSYNC();
        {
            PHASE_IDS();
            const bf16_t* PO = (const bf16_t*)(ws + WS_PO); const float* PML = (const float*)(ws + WS_PML); bf16_t* mix = xn;
            const int th = lane >> 5, h = (lane >> 3) & 3, dc = (lane & 7) * 8;
#pragma unroll 1
            for (int pp = bx; pp < MROWS / 256; pp += G)
#pragma unroll 1
            for (int jj = 0; jj < 4; ++jj) {
                float mm[4][4], ll[4][4]; u32x4 ov[4][4], gwv[4];
#pragma unroll
                for (int u = 0; u < 4; ++u) { const int m = pp * 256 + wid + 8 * (2 * (4 * jj + u) + th); const int pos = m & (SEQ - 1); const int nsel = (pos >> 8) < 3 ? (pos >> 8) : 3;
                    const size_t base = ((size_t)m * 4 + h) * 4;
#pragma unroll
                    for (int sI = 0; sI < 4; ++sI) { const bool on = (sI == 3) || (sI < nsel); const f32x2 ml = on ? *(const f32x2*)(PML + (base + sI) * 2) : (f32x2){-1e30f, 0.f};
                        mm[u][sI] = ml.x; ll[u][sI] = ml.y; ov[u][sI] = on ? *(const u32x4*)(PO + (base + sI) * 64 + dc) : (u32x4){0u, 0u, 0u, 0u}; }
                    gwv[u] = *(const u32x4*)(z + (size_t)m * ZP + Z_MG + h * 64 + dc); }
#pragma unroll
                for (int u = 0; u < 4; ++u) { const int m = pp * 256 + wid + 8 * (2 * (4 * jj + u) + th);
                    const float M4 = fmaxf(fmaxf(mm[u][0], mm[u][1]), fmaxf(mm[u][2], mm[u][3]));
                    float wsum = 0.f, acc[8] = {0.f, 0.f, 0.f, 0.f, 0.f, 0.f, 0.f, 0.f};
#pragma unroll
                    for (int sI = 0; sI < 4; ++sI) { const float w = ll[u][sI] * __builtin_amdgcn_exp2f(mm[u][sI] - M4); wsum += w;
                        const unsigned q4[4] = {ov[u][sI].x, ov[u][sI].y, ov[u][sI].z, ov[u][sI].w};
#pragma unroll
                        for (int e = 0; e < 4; ++e) { acc[2 * e] += w * bf2f(q4[e]); acc[2 * e + 1] += w * bf2f(q4[e] >> 16); } }
                    const float inv = __builtin_amdgcn_rcpf(wsum);
                    const unsigned g4[4] = {gwv[u].x, gwv[u].y, gwv[u].z, gwv[u].w}; unsigned o4[4];
#pragma unroll
                    for (int e = 0; e < 4; ++e) o4[e] = pk2(acc[2 * e] * inv * siluf_(bf2f(g4[e])), acc[2 * e + 1] * inv * siluf_(bf2f(g4[e] >> 16)));
                    *(u32x4*)(mix + (size_t)m * DMODEL + 512 + h * 64 + dc) = (u32x4){o4[0], o4[1], o4[2], o4[3]}; }
            }
            asm volatile("s_waitcnt vmcnt(0)" ::: "memory");
            __syncthreads();
            __builtin_amdgcn_fence(__ATOMIC_ACQUIRE, "agent");
        }
        {
            PHASE_IDS();
            pg8::Gemm g{xn, DMODEL, (const bf16_t*)(ws + WS_W2T) + (size_t)l * 1024 * 1024, MROWS, DMODEL, DMODEL};
            pg8::StaticOrder S; S.init(MROWS, DMODEL, G, bx, true);
            bf16_t* dbuf = (bf16_t*)(ws + WS_QM);
            pg8::EpiZ E{dbuf, DMODEL};
            pg8::gemm_phase<pg8::EpiZ, true>(tid, lds, g, S, E);
            asm volatile("s_waitcnt vmcnt(0)" ::: "memory");
            __syncthreads();
            __builtin_amdgcn_fence(__ATOMIC_ACQUIRE, "agent");
            const float* basep = (l == 0) ? P.in[0] : (const float*)P.out;
#pragma unroll 1
            for (int p = bx; p < MROWS / 256; p += G)
#pragma unroll 1
                for (int r = wid; r < 256; r += 16) { const size_t ra = ((size_t)p * 256 + r) * DMODEL, rb = ra + 8 * DMODEL;
                    if (l + 1 < NLAYER) res_rms_row2(basep + ra, basep + rb, dbuf + ra, dbuf + rb, P.out + ra, P.out + rb, xn + ra, xn + rb, nullptr, nullptr, nullptr, lane);
                    else res_rms_row2(basep + ra, basep + rb, dbuf + ra, dbuf + rb, nullptr, nullptr, nullptr, nullptr, P.out + ra, P.out + rb, P.in[19], lane); }
        }
        if (l + 1 < NLAYER) GSYNC();
    }
}

extern "C" void kernel_launch(void* const* d_in, const int* in_sizes, int n_in, void* d_out, int out_size, void* d_ws, size_t ws_size, hipStream_t stream) {
    static int grid_blocks = 0;
    if (grid_blocks == 0) {
        if (n_in != 20 || ws_size < WS_END) { fprintf(stderr, "kernel_launch: unexpected inputs (n_in %d, ws %zu)\n", n_in, ws_size); grid_blocks = -1; return; }
        int dev = 0, cus = 0, per_cu = 0;
        hipGetDevice(&dev);
        hipDeviceGetAttribute(&cus, hipDeviceAttributeMultiprocessorCount, dev);
        if (hipFuncSetAttribute((const void*)fwd_megakernel, hipFuncAttributeMaxDynamicSharedMemorySize, LDS_BYTES) != hipSuccess) { fprintf(stderr, "kernel_launch: hipFuncSetAttribute failed\n"); grid_blocks = -1; return; }
        if (hipOccupancyMaxActiveBlocksPerMultiprocessor(&per_cu, (const void*)fwd_megakernel, NTHREADS, LDS_BYTES) != hipSuccess || per_cu < 1) { fprintf(stderr, "kernel_launch: occupancy query says %d\n", per_cu); per_cu = 1; }
        (void)hipGetLastError();
        grid_blocks = cus * (per_cu > 1 ? 1 : per_cu);
    }
    if (grid_blocks < 0) return;
    Params p{};
    for (int i = 0; i < 20; ++i) p.in[i] = (const float*)d_in[i];
    p.out = (float*)d_out; p.ws = (unsigned char*)d_ws;
    void* args[] = {&p};
    hipError_t e = hipLaunchCooperativeKernel((const void*)fwd_megakernel, dim3(grid_blocks), dim3(NTHREADS), args, LDS_BYTES, stream);
    if (e != hipSuccess) fprintf(stderr, "cooperative launch failed: %s (grid %d)\n", hipGetErrorString(e), grid_blocks);
}
```

```cpp
#include <hip/hip_runtime.h>
#include <hip/hip_cooperative_groups.h>
#include <cstdint>
#include <cstdio>
namespace cg = cooperative_groups;

#define LAS __attribute__((address_space(3)))
typedef unsigned short bf16_t;
typedef short bf16x8 __attribute__((ext_vector_type(8)));
typedef float f32x4 __attribute__((ext_vector_type(4)));
typedef float f32x2 __attribute__((ext_vector_type(2)));
typedef float f32x16 __attribute__((ext_vector_type(16)));
typedef unsigned u32x4 __attribute__((ext_vector_type(4)));
typedef unsigned u32x2 __attribute__((ext_vector_type(2)));

constexpr int NB = 8, SEQ = 8192, DMODEL = 1024, MROWS = NB * SEQ, ZP = 3584, NLAYER = 2;
constexpr int NTHREADS = 512;
constexpr float LOG2E = 1.4426950408889634f;
constexpr float C2A = 0.125f * 1.4426950408889634f;
constexpr float C2M = 0.10206207261596577f * 1.4426950408889634f;
constexpr int Z_FQ = 0, Z_FK = 320, Z_FV = 640, Z_FG = 896, Z_SU = 1152, Z_SG = 1408, Z_MQ = 1664, Z_MK = 1920, Z_MV = 2176, Z_MG = 2432,
              Z_CQ = 2688, Z_CKV = 3072, Z_KR = 3200, Z_LG = 3232, Z_FF = 3488;
constexpr size_t MiB = 1u << 20;
constexpr size_t WS_CTL = 0;
constexpr size_t WS_W1T = 1 * MiB;
constexpr size_t WS_W2T = 16 * MiB;
constexpr size_t WS_WUQT = 20 * MiB;
constexpr size_t WS_WUKVT = 21 * MiB;
constexpr size_t WS_GLUT = 21 * MiB + 512 * 1024;
constexpr size_t WS_TABM = 22 * MiB;
constexpr size_t WS_TABL = 24 * MiB;
constexpr size_t WS_S5LAM = 25 * MiB;
constexpr size_t WS_S5BB = 25 * MiB + 64 * 1024;
constexpr size_t WS_S5CB = 25 * MiB + 256 * 1024;
constexpr size_t WS_KMH = 26 * MiB;
constexpr size_t WS_KML = 26 * MiB + 128 * 1024;
constexpr size_t WS_RSQ = 27 * MiB;
constexpr size_t WS_RSKV = 27 * MiB + 256 * 1024;
constexpr size_t WS_E = 28 * MiB;
constexpr size_t WS_XIN = 44 * MiB;
constexpr size_t WS_XN = 64 * MiB;
constexpr size_t WS_Z = 192 * MiB;
constexpr size_t WS_QM = 640 * MiB;
constexpr size_t WS_KM = 688 * MiB;
constexpr size_t WS_VM = 736 * MiB;
constexpr size_t WS_PO = 768 * MiB;
constexpr size_t WS_PML = 896 * MiB;
constexpr size_t WS_LIST = 904 * MiB;
constexpr size_t WS_FST = 512 * 1024;
constexpr size_t WS_CUM = 60 * MiB;
constexpr size_t WS_END = 936 * MiB;

constexpr int LDS_BYTES = 150 * 1024;
#ifndef PM
#define PM 0xffff
#endif
#define DBG_REP4 1
#define DBG_REP1 1
#define DBG_ZERO 0

struct Params {
    const float* in[20];
    float* out;
    unsigned char* ws;
};

__device__ __forceinline__ int fresh_tid_(int wave_s) { unsigned m = ~0u; asm volatile("" : "+s"(m)); int t = (wave_s << 6) | (int)__builtin_amdgcn_mbcnt_hi(m, __builtin_amdgcn_mbcnt_lo(m, 0u)); asm volatile("" : "+v"(t)); return t; }
#define fresh_tid() fresh_tid_(wave_s)
__device__ __forceinline__ void gbar(unsigned* bw, unsigned n, unsigned G, unsigned bxu, int tid) {
    asm volatile("s_waitcnt vmcnt(0)" ::: "memory");
    __syncthreads();
    if (tid == 0) {
        __builtin_amdgcn_fence(__ATOMIC_RELEASE, "agent");
        asm volatile("s_waitcnt vmcnt(0)" ::: "memory");
        asm volatile("" : "+s"(G), "+s"(bxu), "+s"(bw));
        const bool two = (G & 7u) == 0u; const unsigned ng = two ? 8u : 1u, gsz = two ? (G >> 3) : G, g = two ? (bxu & 7u) : 0u;
        unsigned* cg_ = bw + 64u * (1u + g); unsigned* top = bw + 64u * 10u; unsigned* gen = bw + 64u * 11u;
        const unsigned old = __hip_atomic_fetch_add(cg_, 1u, __ATOMIC_RELAXED, __HIP_MEMORY_SCOPE_AGENT);
        if (old + 1u == n * gsz) {
            const unsigned old2 = __hip_atomic_fetch_add(top, 1u, __ATOMIC_RELAXED, __HIP_MEMORY_SCOPE_AGENT);
            if (old2 + 1u == n * ng) __hip_atomic_store(gen, n, __ATOMIC_RELAXED, __HIP_MEMORY_SCOPE_AGENT);
        }
        while (__hip_atomic_load(gen, __ATOMIC_RELAXED, __HIP_MEMORY_SCOPE_AGENT) < n) __builtin_amdgcn_s_sleep(1);
        __builtin_amdgcn_fence(__ATOMIC_ACQUIRE, "agent");
        asm volatile("s_waitcnt vmcnt(0)" ::: "memory");
    }
    __syncthreads();
}
typedef __bf16 bf16x2_hw __attribute__((ext_vector_type(2)));
__device__ __forceinline__ unsigned f2bf(float f) { float __attribute__((ext_vector_type(2))) v = {f, 0.f}; bf16x2_hw b = __builtin_convertvector(v, bf16x2_hw); return __builtin_bit_cast(unsigned, b) & 0xffffu; }
__device__ __forceinline__ float bf2f(unsigned b) { return __builtin_bit_cast(float, (b & 0xffffu) << 16); }
typedef __bf16 bf16x2_t __attribute__((ext_vector_type(2)));
__device__ __forceinline__ unsigned cvt_pk_bf16(float lo, float hi) { f32x2 v = {lo, hi}; bf16x2_t b = __builtin_convertvector(v, bf16x2_t); return __builtin_bit_cast(unsigned, b); }
__device__ __forceinline__ unsigned pk2(float lo, float hi) { return cvt_pk_bf16(lo, hi); }
__device__ __forceinline__ int crow(int r, int hi) { return (r & 3) + 8 * (r >> 2) + 4 * hi; }
__device__ __forceinline__ float bperm_f(int srclane, float v) { return __builtin_bit_cast(float, __builtin_amdgcn_ds_bpermute(srclane << 2, __builtin_bit_cast(int, v))); }
__device__ __forceinline__ float wave_sum(float v, int lane) {
#pragma unroll
    for (int o = 1; o < 64; o <<= 1) v += bperm_f(lane ^ o, v);
    return v;
}
__device__ __forceinline__ float other_half_f(float v, int hi) { auto rr = __builtin_amdgcn_permlane32_swap(__builtin_bit_cast(unsigned, v), __builtin_bit_cast(unsigned, v), false, false); return __builtin_bit_cast(float, hi ? rr[0] : rr[1]); }
__device__ __forceinline__ int other_half_i(int v, int hi) { auto rr = __builtin_amdgcn_permlane32_swap((unsigned)v, (unsigned)v, false, false); return (int)(hi ? rr[0] : rr[1]); }
__device__ __forceinline__ float sigmoidf_(float x) { return __builtin_amdgcn_rcpf(1.f + __expf(-x)); }
__device__ __forceinline__ float siluf_(float x) { return x * __builtin_amdgcn_rcpf(1.f + __expf(-x)); }
__device__ __forceinline__ void sincos_acc(float ang, float& s, float& c) {
    const double a = (double)ang;
    const double q = rint(a * 0.63661977236758134308);
    const double y = fma(-q, 1.57079632679489661923, a) - q * 6.123233995736766e-17;
    const double y2 = y * y;
    double sp = -1.0 / 6227020800.0; sp = sp * y2 + 1.0 / 39916800.0; sp = sp * y2 - 1.0 / 362880.0; sp = sp * y2 + 1.0 / 5040.0; sp = sp * y2 - 1.0 / 120.0; sp = sp * y2 + 1.0 / 6.0;
    const double sy = y - y * y2 * sp;
    double cp = 1.0 / 479001600.0; cp = cp * y2 - 1.0 / 3628800.0; cp = cp * y2 + 1.0 / 40320.0; cp = cp * y2 - 1.0 / 720.0; cp = cp * y2 + 1.0 / 24.0; cp = cp * y2 - 0.5;
    const double cy = 1.0 + y2 * cp;
    const int qi = ((int)q) & 3;
    const double ss = (qi == 0) ? sy : (qi == 1) ? cy : (qi == 2) ? -sy : -cy;
    const double cc = (qi == 0) ? cy : (qi == 1) ? -sy : (qi == 2) ? -cy : sy;
    s = (float)ss; c = (float)cc;
}

__device__ __forceinline__ size_t kt_off(int row, int h, int chunk) { const int b = row >> 13, t = row & (SEQ - 1); return ((((size_t)(b * 4 + h) * 128 + (t >> 6)) * 12 + chunk) * 64 + (t & 63)) * 8; }
__device__ __forceinline__ size_t vt_off(int row, int h, int d) { const int b = row >> 13, t = row & (SEQ - 1); const int w = (d >> 5) * 4 + ((t >> 4) & 3), ln = (t & 15) * 4 + ((d >> 3) & 3);
    return ((((size_t)(b * 4 + h) * 128 + (t >> 6)) * 8 + w) * 64 + ln) * 8 + (d & 7); }
namespace pg8 {
constexpr int BM = 256, BK = 64, HALF = 128, HTB = HALF * BK * 2, STAGE_BYTES = 8 * HTB, NXCD = 8, WGM = 8;
__device__ __forceinline__ int lds_byte(int r, int c) { const int st = (r >> 4) * 2 + (c >> 5), rr = r & 15, cc = c & 31, ob = rr * 64 + cc * 2; return st * 1024 + (ob ^ (((ob >> 9) & 1) << 5)); }
__device__ __forceinline__ void stage_rc(int b, int& R, int& C) { const int st = b / 1024, sb = b % 1024, swz = sb ^ (((sb >> 9) & 1) << 5); R = (st >> 1) * 16 + swz / 64; C = (st & 1) * 32 + (swz % 64) / 2; }
__device__ __forceinline__ int perm32(int rho) { const int n = rho >> 4, i = rho & 15; return 8 * (i >> 2) + 4 * n + (i & 3); }
struct Unit { int pm, pn; };
struct Gemm { const bf16_t* A; int lda; const bf16_t* Bt; int M, N, K; };
struct StaticOrder {
    int nM, nN, nwg, G, c; bool panel;
    __device__ void init(int M, int N, int G_, int c_, bool panel_ = false) { nM = M / BM; nN = N / BM; nwg = nM * nN; G = G_; c = c_; panel = panel_; }
    __device__ bool next(int i, Unit& u) const {
        if (panel) { const int p = c + (i / nN) * G; if (p >= nM) return false; u.pm = p; u.pn = (i + c) % nN; return true; }
        const long L = (long)i * G + c; if (L >= nwg) return false;
        int wgid = (int)L; { const int q = nwg / NXCD, r = nwg % NXCD, xcd = wgid % NXCD, off = wgid / NXCD; wgid = (xcd < r ? xcd * (q + 1) : r * (q + 1) + (xcd - r) * q) + off; }
        const int nig = WGM * nN, gid = wgid / nig, fm = gid * WGM, gsz = (nM - fm) < WGM ? (nM - fm) : WGM;
        u.pm = fm + ((wgid % nig) % gsz); u.pn = (wgid % nig) / gsz; return true;
    }
};
template <class Epi, bool ALIGN_EPI>
__device__ __forceinline__ void gemm_phase(int tid, LAS unsigned char* lds, const Gemm g, const StaticOrder& S, const Epi& E) {
    const int wid = __builtin_amdgcn_readfirstlane(tid >> 6), lane = tid & 63, wr = wid >> 2, wc = wid & 3, fr = lane & 15, fq = lane >> 4;
    const int K = g.K, nt = K / BK, lda = g.lda;
    unsigned voffA[2], voffB[2];
#pragma unroll
    for (int i = 0; i < 2; ++i) { int R, C; stage_rc(tid * 16 + i * 8192, R, C); const int Rb = Epi::PERM ? ((R & ~31) + perm32(R & 31)) : R;
        voffA[i] = (unsigned)(R * lda + C) * 2u; voffB[i] = (unsigned)(Rb * K + C) * 2u; }
    const unsigned kstep = (unsigned)(BK * 2);
    const unsigned hstepA = (unsigned)HALF * lda * 2u, hstepB = (unsigned)HALF * K * 2u;
    const unsigned tstepA = 2u * hstepA, tstepB = 2u * hstepB;
    const unsigned ldsw = (unsigned)wid * 1024u;
    const int aoff = lds_byte(wr * 64 + fr, fq * 8), boff = lds_byte(wc * 32 + fr, fq * 8);
    const char* const baseA = (const char*)g.A; const char* const baseB = (const char*)g.Bt;
#define PG8_SA(b, h) (((b) * 2 + (h)) * HTB)
#define PG8_SB(b, h) ((4 + (b) * 2 + (h)) * HTB)
#define PG8_STAGE(bufoff, gbase, uoff, voff) do { _Pragma("unroll") for (int _i = 0; _i < 2; ++_i) \
        __builtin_amdgcn_global_load_lds((const unsigned*)((gbase) + (size_t)(unsigned)((uoff) + (voff)[_i])), (LAS unsigned*)(lds + (bufoff) + ldsw + _i * 8192), 16, 0, 0); } while (0)
#define PG8_LDA(dst, b, h) do { _Pragma("unroll") for (int m = 0; m < 4; ++m) _Pragma("unroll") for (int k = 0; k < 2; ++k) dst[m][k] = *(const LAS bf16x8*)(lds + PG8_SA(b, h) + aoff + m * 2048 + k * 1024); } while (0)
#define PG8_LDB(dst, b, h) do { _Pragma("unroll") for (int n = 0; n < 2; ++n) _Pragma("unroll") for (int k = 0; k < 2; ++k) dst[n][k] = *(const LAS bf16x8*)(lds + PG8_SB(b, h) + boff + n * 2048 + k * 1024); } while (0)
#define PG8_MMA(ai, bj, At, Bt) do { __builtin_amdgcn_s_setprio(1); _Pragma("unroll") for (int m = 0; m < 4; ++m) _Pragma("unroll") for (int n = 0; n < 2; ++n) _Pragma("unroll") for (int k = 0; k < 2; ++k) \
        acc[ai][bj][m][n] = __builtin_amdgcn_mfma_f32_16x16x32_bf16(Bt[n][k], At[m][k], acc[ai][bj][m][n], 0, 0, 0); __builtin_amdgcn_s_setprio(0); } while (0)
#define PG8_WAIT_V(n) asm volatile("s_waitcnt vmcnt(" #n ")" ::: "memory")
#define PG8_WAIT_L(n) asm volatile("s_waitcnt lgkmcnt(" #n ")" ::: "memory")
#define PG8_BAR __builtin_amdgcn_s_barrier()
#define PG8_SCHED __builtin_amdgcn_sched_barrier(0)
    Unit cur, nxt; int ui = 0;
    if (!S.next(0, cur)) return;
    f32x4 acc[2][2][4][2];
#pragma unroll
    for (int a = 0; a < 2; ++a)
#pragma unroll
        for (int b = 0; b < 2; ++b)
#pragma unroll
            for (int m = 0; m < 4; ++m)
#pragma unroll
                for (int n = 0; n < 2; ++n) acc[a][b][m][n] = (f32x4){0.f, 0.f, 0.f, 0.f};
    bf16x8 At[4][2], B0[2][2], B1[2][2];
    unsigned cA = (unsigned)cur.pm * tstepA, cB = (unsigned)cur.pn * tstepB;
    PG8_STAGE(PG8_SB(0, 0), baseB, cB, voffB); PG8_STAGE(PG8_SB(0, 1), baseB, cB + hstepB, voffB); PG8_STAGE(PG8_SA(0, 0), baseA, cA, voffA); PG8_STAGE(PG8_SA(0, 1), baseA, cA + hstepA, voffA);
    if (wr == 1) PG8_BAR;
    PG8_WAIT_V(2); PG8_BAR;
    PG8_STAGE(PG8_SB(1, 0), baseB, cB + kstep, voffB); PG8_STAGE(PG8_SA(1, 0), baseA, cA + kstep, voffA); PG8_STAGE(PG8_SB(1, 1), baseB, cB + hstepB + kstep, voffB);
    PG8_WAIT_V(6); PG8_BAR;
    for (;;) {
        const bool has_next = S.next(ui + 1, nxt);
        const unsigned nA = has_next ? (unsigned)nxt.pm * tstepA : cA; const unsigned nB = has_next ? (unsigned)nxt.pn * tstepB : cB;
        for (int t = 0; t < nt; t += 2) {
            const bool last = (t == nt - 2);
            const unsigned a1 = cA + (unsigned)(t + 1) * kstep;
            const unsigned a2 = last ? nA : cA + (unsigned)(t + 2) * kstep; const unsigned b2 = last ? nB : cB + (unsigned)(t + 2) * kstep;
            const unsigned a3 = a2 + kstep; const unsigned b3 = b2 + kstep;
            PG8_LDB(B0, 0, 0); PG8_LDB(B1, 0, 1); PG8_SCHED; PG8_LDA(At, 0, 0); PG8_STAGE(PG8_SA(1, 1), baseA, a1 + hstepA, voffA);
            PG8_WAIT_V(8); PG8_WAIT_L(0); PG8_BAR; PG8_MMA(0, 0, At, B0); PG8_MMA(0, 1, At, B1); PG8_BAR; PG8_SCHED;
            PG8_LDA(At, 0, 1); PG8_STAGE(PG8_SB(0, 0), baseB, b2, voffB); PG8_STAGE(PG8_SB(0, 1), baseB, b2 + hstepB, voffB); PG8_STAGE(PG8_SA(0, 0), baseA, a2, voffA);
            PG8_WAIT_V(8); PG8_WAIT_L(0); PG8_BAR; PG8_MMA(1, 0, At, B0); PG8_MMA(1, 1, At, B1); PG8_BAR; PG8_SCHED;
            PG8_LDB(B0, 1, 0); PG8_LDB(B1, 1, 1); PG8_SCHED; PG8_LDA(At, 1, 0); PG8_STAGE(PG8_SA(0, 1), baseA, a2 + hstepA, voffA);
            PG8_WAIT_V(8); PG8_WAIT_L(0); PG8_BAR; PG8_MMA(0, 0, At, B0); PG8_MMA(0, 1, At, B1); PG8_BAR; PG8_SCHED;
            PG8_LDA(At, 1, 1); PG8_STAGE(PG8_SB(1, 0), baseB, b3, voffB); PG8_STAGE(PG8_SB(1, 1), baseB, b3 + hstepB, voffB); PG8_STAGE(PG8_SA(1, 0), baseA, a3, voffA);
            PG8_WAIT_V(8); PG8_WAIT_L(0); PG8_BAR; PG8_MMA(1, 0, At, B0); PG8_MMA(1, 1, At, B1); PG8_BAR; PG8_SCHED;
        }
        if constexpr (ALIGN_EPI) { if (wr == 0) PG8_BAR; }
        E(acc, cur, wr, wc, fr, fq);
        if (!has_next) break;
#pragma unroll
        for (int a = 0; a < 2; ++a)
#pragma unroll
            for (int b = 0; b < 2; ++b)
#pragma unroll
                for (int m = 0; m < 4; ++m)
#pragma unroll
                    for (int n = 0; n < 2; ++n) acc[a][b][m][n] = (f32x4){0.f, 0.f, 0.f, 0.f};
        cur = nxt; cA = nA; cB = nB; ++ui;
        if constexpr (ALIGN_EPI) { if (wr == 1) PG8_BAR; }
    }
    PG8_WAIT_V(0);
    if constexpr (!ALIGN_EPI) { if (wr == 0) PG8_BAR; }
    PG8_BAR;
#undef PG8_SA
#undef PG8_SB
#undef PG8_STAGE
#undef PG8_LDA
#undef PG8_LDB
#undef PG8_MMA
#undef PG8_WAIT_V
#undef PG8_WAIT_L
#undef PG8_BAR
#undef PG8_SCHED
}
struct EpiZ {
    static constexpr bool PERM = true;
    bf16_t* O; int ldc;
    __device__ __forceinline__ void operator()(const f32x4 (&acc)[2][2][4][2], const Unit& u, int wr, int wc, int fr, int fq) const {
        const int row0 = u.pm * BM + wr * 64 + fr; const int col0 = u.pn * BM + wc * 32 + 8 * fq;
#pragma unroll
        for (int ai = 0; ai < 2; ++ai)
#pragma unroll
            for (int m = 0; m < 4; ++m) { bf16_t* rowp = O + (size_t)(row0 + ai * HALF + m * 16) * ldc + col0;
#pragma unroll
                for (int bj = 0; bj < 2; ++bj) { const f32x4 v0 = acc[ai][bj][m][0], v1 = acc[ai][bj][m][1];
                    u32x4 w; w.x = cvt_pk_bf16(v0[0], v0[1]); w.y = cvt_pk_bf16(v0[2], v0[3]); w.z = cvt_pk_bf16(v1[0], v1[1]); w.w = cvt_pk_bf16(v1[2], v1[3]);
                    *(u32x4*)(rowp + bj * HALF) = w; } }
    }
};
struct EpiMlaQ {
    static constexpr bool PERM = true;
    bf16_t* O; const float* rs;
    __device__ __forceinline__ void operator()(const f32x4 (&acc)[2][2][4][2], const Unit& u, int wr, int wc, int fr, int fq) const {
        const int row0 = u.pm * BM + wr * 64 + fr; const int col0 = u.pn * BM + wc * 32 + 8 * fq;
#pragma unroll
        for (int ai = 0; ai < 2; ++ai)
#pragma unroll
            for (int m = 0; m < 4; ++m) { asm volatile("" ::: "memory"); const int row = row0 + ai * HALF + m * 16; const float sc = rs[row] * C2M; bf16_t* rowp = O + (size_t)row * 384 + col0;
#pragma unroll
                for (int bj = 0; bj < 2; ++bj) { if (col0 + bj * HALF < 384) { const f32x4 v0 = acc[ai][bj][m][0] * sc, v1 = acc[ai][bj][m][1] * sc;
                    u32x4 w; w.x = cvt_pk_bf16(v0[0], v0[1]); w.y = cvt_pk_bf16(v0[2], v0[3]); w.z = cvt_pk_bf16(v1[0], v1[1]); w.w = cvt_pk_bf16(v1[2], v1[3]);
                    *(u32x4*)(rowp + bj * HALF) = w; } } }
    }
};
struct EpiMlaKV {
    static constexpr bool PERM = true;
    bf16_t* KMp; bf16_t* VMp; const float* rs;
    __device__ __forceinline__ void operator()(const f32x4 (&acc)[2][2][4][2], const Unit& u, int wr, int wc, int fr, int fq) const {
        const int row0 = u.pm * BM + wr * 64 + fr; const int colt = wc * 32 + 8 * fq;
#pragma unroll
        for (int ai = 0; ai < 2; ++ai)
#pragma unroll
            for (int m = 0; m < 4; ++m) { asm volatile("" ::: "memory"); const int row = row0 + ai * HALF + m * 16; const float sc = rs[row];
#pragma unroll
                for (int bj = 0; bj < 2; ++bj) { const int c = colt + bj * HALF; const f32x4 v0 = acc[ai][bj][m][0] * sc, v1 = acc[ai][bj][m][1] * sc;
                    u32x4 w; w.x = cvt_pk_bf16(v0[0], v0[1]); w.y = cvt_pk_bf16(v0[2], v0[3]); w.z = cvt_pk_bf16(v1[0], v1[1]); w.w = cvt_pk_bf16(v1[2], v1[3]);
                    bf16_t* dst = (u.pn == 0) ? (KMp + kt_off(row, c >> 6, (c & 63) >> 3)) : (VMp + vt_off(row, c >> 6, c & 63));
                    *(u32x4*)dst = w; } }
    }
};
struct EpiRes {
    static constexpr bool PERM = false;
    const float* base; float* out;
    __device__ __forceinline__ void operator()(const f32x4 (&acc)[2][2][4][2], const Unit& u, int wr, int wc, int fr, int fq) const {
        const int row0 = u.pm * BM + wr * 64 + fr; const int col0 = u.pn * BM + wc * 32 + 4 * fq;
#pragma unroll
        for (int ai = 0; ai < 2; ++ai)
#pragma unroll
            for (int m = 0; m < 4; ++m) { const size_t off = (size_t)(row0 + ai * HALF + m * 16) * DMODEL + col0;
#pragma unroll
                for (int bj = 0; bj < 2; ++bj)
#pragma unroll
                    for (int n = 0; n < 2; ++n) { const f32x4 bs = *(const f32x4*)(base + off + bj * HALF + n * 16); *(f32x4*)(out + off + bj * HALF + n * 16) = bs + acc[ai][bj][m][n]; } }
    }
};
}

__device__ __forceinline__ int colmap(int kind, int n, float& sc) {
    sc = 1.f;
    if (kind == 1) return n;
    if (kind == 2) return n < 384 ? n : -1;
    if (kind == 3) { const int nn = n & 255, h = nn >> 6, d = nn & 63; return h * 128 + d + ((n >= 256) ? 64 : 0); }
    if (n < 320) { const int h = n / 80, d = n % 80; sc = C2A; return d < 64 ? h * 64 + d : -1; }
    if (n < 640) { const int nn = n - 320, h = nn / 80, d = nn % 80; return d < 64 ? 256 + h * 64 + d : -1; }
    if (n < 896) return 512 + (n - 640);
    if (n < 1152) return 768 + (n - 896);
    if (n < 1408) return 1028 + (n - 1152);
    if (n < 1664) return 1284 + (n - 1408);
    if (n < 1920) { sc = C2A; return 1540 + (n - 1664); }
    if (n < 2176) return 1796 + (n - 1920);
    if (n < 2432) return 2052 + (n - 2176);
    if (n < 2688) return 2308 + (n - 2432);
    if (n < 3072) return 2564 + (n - 2688);
    if (n < 3200) return 2948 + (n - 3072);
    if (n < 3232) return 3076 + (n - 3200);
    if (n < 3488) return 3108 + (n - 3232);
    if (n < 3492) return 1024 + (n - 3488);
    return -1;
}
__device__ __forceinline__ void tconv_item(int tid, const float* W, int ldw, int kind, const float* rs, bf16_t* O, int K, int k0, int n0, LAS float* scr) {
#pragma unroll
    for (int i = 0; i < 8; ++i) { const int idx = tid + 512 * i, kk = idx >> 6, nn = idx & 63; float sc; const int src = colmap(kind, n0 + nn, sc);
        float v = 0.f; if (src >= 0) { v = W[(size_t)(k0 + kk) * ldw + src] * sc; if (rs) v *= rs[k0 + kk]; }
        scr[kk * 65 + nn] = v; }
    __syncthreads();
    { const int nn = tid >> 3, c = tid & 7; const LAS float* s = scr + (8 * c) * 65 + nn;
      u32x4 o; o.x = pk2(s[0], s[65]); o.y = pk2(s[2 * 65], s[3 * 65]); o.z = pk2(s[4 * 65], s[5 * 65]); o.w = pk2(s[6 * 65], s[7 * 65]);
      *(u32x4*)(O + (size_t)(n0 + nn) * K + k0 + 8 * c) = o; }
    __syncthreads();
}
__device__ __forceinline__ void rms_row2(const float* xa, const float* xb, bf16_t* oa, bf16_t* obb, float* fa, float* fb, const float* g, int lane) {
    const f32x4* ra = (const f32x4*)xa + lane; const f32x4* rb = (const f32x4*)xb + lane;
    f32x4 va[4], vb[4]; float sa = 0.f, sb = 0.f;
#pragma unroll
    for (int j = 0; j < 4; ++j) { va[j] = ra[64 * j]; vb[j] = rb[64 * j]; }
#pragma unroll
    for (int j = 0; j < 4; ++j) { sa += (va[j].x * va[j].x + va[j].y * va[j].y) + (va[j].z * va[j].z + va[j].w * va[j].w); sb += (vb[j].x * vb[j].x + vb[j].y * vb[j].y) + (vb[j].z * vb[j].z + vb[j].w * vb[j].w); }
#pragma unroll
    for (int o = 1; o < 64; o <<= 1) { sa += bperm_f(lane ^ o, sa); sb += bperm_f(lane ^ o, sb); }
    const float rsa = 1.f / sqrtf(sa * (1.f / DMODEL) + 1e-6f), rsb = 1.f / sqrtf(sb * (1.f / DMODEL) + 1e-6f);
    if (oa) {
        u32x2* o8a = (u32x2*)oa + lane; u32x2* o8b = (u32x2*)obb + lane;
#pragma unroll
        for (int j = 0; j < 4; ++j) { u32x2 w; w.x = pk2(va[j].x * rsa, va[j].y * rsa); w.y = pk2(va[j].z * rsa, va[j].w * rsa); o8a[64 * j] = w;
            u32x2 w2; w2.x = pk2(vb[j].x * rsb, vb[j].y * rsb); w2.y = pk2(vb[j].z * rsb, vb[j].w * rsb); o8b[64 * j] = w2; }
    } else {
        const f32x4* gr = (const f32x4*)g + lane; f32x4* o1 = (f32x4*)fa + lane; f32x4* o2 = (f32x4*)fb + lane;
#pragma unroll
        for (int j = 0; j < 4; ++j) { const f32x4 gg = gr[64 * j]; o1[64 * j] = va[j] * rsa * gg; o2[64 * j] = vb[j] * rsb * gg; }
    }
}
__device__ __forceinline__ void res_rms_row2(const float* xa, const float* xb, const bf16_t* da, const bf16_t* db, float* keepa, float* keepb, bf16_t* na, bf16_t* nb,
                                             float* fina, float* finb, const float* g, int lane) {
    const f32x4* ra = (const f32x4*)xa + lane; const f32x4* rb = (const f32x4*)xb + lane;
    const u32x2* qa = (const u32x2*)da + lane; const u32x2* qb = (const u32x2*)db + lane;
    f32x4 va[4], vb[4]; u32x2 ea[4], eb[4]; float sa = 0.f, sb = 0.f;
#pragma unroll
    for (int j = 0; j < 4; ++j) { va[j] = ra[64 * j]; vb[j] = rb[64 * j]; ea[j] = qa[64 * j]; eb[j] = qb[64 * j]; }
#pragma unroll
    for (int j = 0; j < 4; ++j) {
        va[j].x += bf2f(ea[j].x); va[j].y += bf2f(ea[j].x >> 16); va[j].z += bf2f(ea[j].y); va[j].w += bf2f(ea[j].y >> 16);
        vb[j].x += bf2f(eb[j].x); vb[j].y += bf2f(eb[j].x >> 16); vb[j].z += bf2f(eb[j].y); vb[j].w += bf2f(eb[j].y >> 16);
        sa += (va[j].x * va[j].x + va[j].y * va[j].y) + (va[j].z * va[j].z + va[j].w * va[j].w); sb += (vb[j].x * vb[j].x + vb[j].y * vb[j].y) + (vb[j].z * vb[j].z + vb[j].w * vb[j].w); }
#pragma unroll
    for (int o = 1; o < 64; o <<= 1) { sa += bperm_f(lane ^ o, sa); sb += bperm_f(lane ^ o, sb); }
    const float rsa = 1.f / sqrtf(sa * (1.f / DMODEL) + 1e-6f), rsb = 1.f / sqrtf(sb * (1.f / DMODEL) + 1e-6f);
    if (keepa) {
        f32x4* k1 = (f32x4*)keepa + lane; f32x4* k2 = (f32x4*)keepb + lane; u32x2* o8a = (u32x2*)na + lane; u32x2* o8b = (u32x2*)nb + lane;
#pragma unroll
        for (int j = 0; j < 4; ++j) { k1[64 * j] = va[j]; k2[64 * j] = vb[j];
            u32x2 w; w.x = pk2(va[j].x * rsa, va[j].y * rsa); w.y = pk2(va[j].z * rsa, va[j].w * rsa); o8a[64 * j] = w;
            u32x2 w2; w2.x = pk2(vb[j].x * rsb, vb[j].y * rsb); w2.y = pk2(vb[j].z * rsb, vb[j].w * rsb); o8b[64 * j] = w2; }
    } else {
        const f32x4* gr = (const f32x4*)g + lane; f32x4* o1 = (f32x4*)fina + lane; f32x4* o2 = (f32x4*)finb + lane;
#pragma unroll
        for (int j = 0; j < 4; ++j) { const f32x4 gg = gr[64 * j]; o1[64 * j] = va[j] * rsa * gg; o2[64 * j] = vb[j] * rsb * gg; }
    }
}
__device__ __forceinline__ void rms_row(const float* xrow, bf16_t* ob, float* of, const float* g, int lane) {
    const f32x4* xr = (const f32x4*)xrow + lane;
    f32x4 v[4]; float s = 0.f;
#pragma unroll
    for (int j = 0; j < 4; ++j) { v[j] = xr[64 * j]; s += (v[j].x * v[j].x + v[j].y * v[j].y) + (v[j].z * v[j].z + v[j].w * v[j].w); }
    const float rstd = 1.f / sqrtf(wave_sum(s, lane) * (1.f / DMODEL) + 1e-6f);
    if (ob) {
        u32x2* o8 = (u32x2*)ob + lane;
#pragma unroll
        for (int j = 0; j < 4; ++j) { u32x2 w; w.x = pk2(v[j].x * rstd, v[j].y * rstd); w.y = pk2(v[j].z * rstd, v[j].w * rstd); o8[64 * j] = w; }
    } else {
        const f32x4* gr = (const f32x4*)g + lane; f32x4* o = (f32x4*)of + lane;
#pragma unroll
        for (int j = 0; j < 4; ++j) { const f32x4 gg = gr[64 * j]; o[64 * j] = v[j] * rstd * gg; }
    }
}

template <bool FINAL>
__device__ __forceinline__ void s5_item(int tid, const Params& P, int l, int b, int c, LAS unsigned char* lds) {
    const int lane = tid & 63, wid = __builtin_amdgcn_readfirstlane(tid >> 6), r32 = lane & 31, hi = lane >> 5;
    unsigned char* ws = P.ws;
    const bf16_t* z = (const bf16_t*)(ws + WS_Z);
    const float* lamt = (const float*)(ws + WS_S5LAM);
    const bf16_t* Bb = (const bf16_t*)(ws + WS_S5BB);
    const bf16_t* Cb = (const bf16_t*)(ws + WS_S5CB);
    float* E = (float*)(ws + WS_E); const float* XIN = (const float*)(ws + WS_XIN);
    LAS float* scr = (LAS float*)(lds + wid * 16384);
    LAS bf16_t* Xs = (LAS bf16_t*)scr;
    LAS bf16_t* Ys = (LAS bf16_t*)(lds + 131072);
    const int row0 = b * SEQ + c * 32;
    bf16x8 ua[2], bb[2][4]; f32x4 lm[2]; float xr0[2], xi0[2];
#pragma unroll
    for (int gi = 0; gi < 2; ++gi) {
        const int g = wid * 2 + gi;
        ua[gi] = *(const bf16x8*)(z + (size_t)(row0 + r32) * ZP + Z_SU + g * 16 + 8 * hi);
#pragma unroll
        for (int nt = 0; nt < 4; ++nt) bb[gi][nt] = *(const bf16x8*)(Bb + ((size_t)(l * 16 + g) * 128 + nt * 32 + r32) * 16 + 8 * hi);
        lm[gi] = *(const f32x4*)(lamt + ((size_t)(l * 16 + g) * 64 + lane) * 4);
        const size_t sidx = ((size_t)(b * 256 + c) * 16 + g) * 128 + lane;
        xr0[gi] = 0.f; xi0[gi] = 0.f;
        if (FINAL) { xr0[gi] = XIN[sidx]; xi0[gi] = XIN[sidx + 64]; }
    }
    __builtin_amdgcn_sched_barrier(0);
#pragma unroll
    for (int gi = 0; gi < 2; ++gi) {
        const int g = wid * 2 + gi;
        bf16x8 cbv[8]; float dcv = 0.f, uv[16];
        if (FINAL) {
#pragma unroll
            for (int ks = 0; ks < 8; ++ks) cbv[ks] = *(const bf16x8*)(Cb + ((size_t)(l * 16 + g) * 32 + r32) * 128 + 16 * ks + 8 * hi);
            const int chp = g * 16 + (r32 & 15); dcv = P.in[11][l * 256 + chp];
#pragma unroll
            for (int r = 0; r < 16; ++r) uv[r] = bf2f(z[(size_t)(row0 + crow(r, hi)) * ZP + Z_SU + chp]); }
        f32x16 bu[4];
#pragma unroll
        for (int nt = 0; nt < 4; ++nt) { f32x16 zz = {}; bu[nt] = __builtin_amdgcn_mfma_f32_32x32x16_bf16(ua[gi], bb[gi][nt], zz, 0, 0, 0); }
#pragma unroll
        for (int nt = 0; nt < 4; ++nt)
#pragma unroll
            for (int r = 0; r < 16; ++r) scr[crow(r, hi) * 128 + nt * 32 + r32] = bu[nt][r];
        asm volatile("s_waitcnt lgkmcnt(0)" ::: "memory");
        const int p = lane;
        const size_t sidx = ((size_t)(b * 256 + c) * 16 + g) * 128 + p;
        float xr = xr0[gi], xi = xi0[gi];
        float br[32], bi[32];
#pragma unroll
        for (int t = 0; t < 32; ++t) { br[t] = scr[t * 128 + p]; bi[t] = scr[t * 128 + 64 + p]; }
        asm volatile("s_waitcnt lgkmcnt(0)" ::: "memory");
#pragma unroll
        for (int t = 0; t < 32; ++t) {
            const float nr = lm[gi].x * xr - lm[gi].y * xi + br[t], ni = lm[gi].x * xi + lm[gi].y * xr + bi[t]; xr = nr; xi = ni;
            if (FINAL) { const unsigned w = cvt_pk_bf16(xr, xi); Xs[t * 136 + p] = (bf16_t)(w & 0xffffu); Xs[t * 136 + 64 + p] = (bf16_t)(w >> 16); }
        }
        if (!FINAL) { E[sidx] = xr; E[sidx + 64] = xi; }
        asm volatile("" ::: "memory");
        if (FINAL) {
            f32x16 y = {};
#pragma unroll
            for (int ks = 0; ks < 8; ++ks) { const bf16x8 xa = *(const LAS bf16x8*)(Xs + r32 * 136 + 16 * ks + 8 * hi);
                y = __builtin_amdgcn_mfma_f32_32x32x16_bf16(xa, cbv[ks], y, 0, 0, 0); }
            if (r32 < 16) { const int ch = g * 16 + r32;
#pragma unroll
                for (int r = 0; r < 16; ++r) { const int t = crow(r, hi);
                    float v = y[r] + dcv * uv[r]; const float a = 0.7978845608028654f * (v + 0.044715f * v * v * v); const float th = 1.f - 2.f * __builtin_amdgcn_rcpf(__expf(2.f * a) + 1.f); v = 0.5f * v * (1.f + th);
                    Ys[t * 264 + ch] = (bf16_t)f2bf(v); } }
        }
        asm volatile("s_waitcnt lgkmcnt(0)" ::: "memory");
    }
    if (FINAL) {
        const bf16_t* GLUt = (const bf16_t*)(ws + WS_GLUT) + (size_t)l * 65536;
        bf16_t* mix = (bf16_t*)(ws + WS_XN);
        const int n = 32 * wid + r32; const float bias = P.in[13][l * 256 + n];
        bf16x8 gbv[16]; float sgv[16];
#pragma unroll
        for (int ks = 0; ks < 16; ++ks) gbv[ks] = *(const bf16x8*)(GLUt + (size_t)(32 * wid + r32) * 256 + 16 * ks + 8 * hi);
#pragma unroll
        for (int r = 0; r < 16; ++r) sgv[r] = bf2f(z[(size_t)(row0 + crow(r, hi)) * ZP + Z_SG + n]);
        __syncthreads();
        f32x16 acc = {};
#pragma unroll
        for (int ks = 0; ks < 16; ++ks) { const bf16x8 ya = *(const LAS bf16x8*)(Ys + r32 * 264 + 16 * ks + 8 * hi);
            acc = __builtin_amdgcn_mfma_f32_32x32x16_bf16(ya, gbv[ks], acc, 0, 0, 0); }
#pragma unroll
        for (int r = 0; r < 16; ++r) { const int t = crow(r, hi); const float yv = bf2f(Ys[t * 264 + n]); const float lin = acc[r] + bias;
            const float sg = sgv[r];
            mix[(size_t)(row0 + t) * DMODEL + 256 + n] = ((DBG_ZERO >> 1) & 1) ? (bf16_t)0 : (bf16_t)f2bf(yv * sigmoidf_(lin) * siluf_(sg)); }
        __syncthreads();
    }
}

typedef short s16x4 __attribute__((ext_vector_type(4)));
__device__ __forceinline__ s16x4 vtr(const LAS unsigned char* p) { return __builtin_bit_cast(s16x4, __builtin_amdgcn_ds_read_tr16_b64_v4i16((LAS s16x4*)p)); }
__device__ __forceinline__ void glds16(const void* gsrc, unsigned lds_dst) { unsigned keep;
    asm volatile("s_mov_b32 %0, m0\n\ts_mov_b32 m0, %2\n\ts_nop 0\n\tglobal_load_lds_dwordx4 %1, off\n\ts_mov_b32 m0, %0" : "=&s"(keep) : "v"(gsrc), "s"(lds_dst) : "memory"); }
struct AttnPtrs { const bf16_t* Q; int qp; const bf16_t* K; int kp; const bf16_t* V; int vp; const bf16_t* G; bf16_t* O; };
__device__ __forceinline__ void moba_select(int tid, const Params& P, int b, int h, int qb) {
    const int lane = tid & 63, wid = __builtin_amdgcn_readfirstlane(tid >> 6), r32 = lane & 31, hi = lane >> 5;
    const int pos = qb * 256 + wid * 32 + r32;
    const bf16_t* Q = (const bf16_t*)(P.ws + WS_Z) + ((size_t)b * SEQ + pos) * ZP + Z_MQ + h * 64;
    bf16x8 qr[4];
#pragma unroll
    for (int d0 = 0; d0 < 4; ++d0) qr[d0] = *(const bf16x8*)(Q + 16 * d0 + 8 * hi);
    { const float* tab = (const float*)(P.ws + WS_TABM) + (size_t)pos * 64;
#pragma unroll
      for (int d0 = 0; d0 < 2; ++d0) { const int i0 = 16 * d0 + 8 * hi; bf16x8 a = qr[d0], c2 = qr[d0 + 2];
#pragma unroll
        for (int e = 0; e < 8; ++e) { const float cs = tab[i0 + e], sn = tab[32 + i0 + e]; const float x1 = bf2f((unsigned short)a[e]), x2 = bf2f((unsigned short)c2[e]);
            a[e] = (short)f2bf(x1 * cs - x2 * sn); c2[e] = (short)f2bf(x1 * sn + x2 * cs); }
        qr[d0] = a; qr[d0 + 2] = c2; } }
    unsigned sel = 0u;
    {
        const bf16_t* kmh = (const bf16_t*)(P.ws + WS_KMH) + (size_t)((b * 4 + h) * 32 + r32) * 64;
        const bf16_t* kml = (const bf16_t*)(P.ws + WS_KML) + (size_t)((b * 4 + h) * 32 + r32) * 64;
        f32x16 gt = {};
#pragma unroll
        for (int d0 = 0; d0 < 4; ++d0) { const bf16x8 ah = *(const bf16x8*)(kmh + 16 * d0 + 8 * hi), al = *(const bf16x8*)(kml + 16 * d0 + 8 * hi);
            gt = __builtin_amdgcn_mfma_f32_32x32x16_bf16(ah, qr[d0], gt, 0, 0, 0); gt = __builtin_amdgcn_mfma_f32_32x32x16_bf16(al, qr[d0], gt, 0, 0, 0); }
#pragma unroll
        for (int r = 0; r < 16; ++r) if (crow(r, hi) >= qb) gt[r] = -INFINITY;
        sel = 0u;
#pragma unroll 1
        for (int round = 0; round < 3; ++round) {
            float bv = -INFINITY; int bi = 99;
#pragma unroll
            for (int r = 0; r < 16; ++r) if (gt[r] > bv) { bv = gt[r]; bi = crow(r, hi); }
            const float ov = other_half_f(bv, hi); const int oi = other_half_i(bi, hi);
            const bool mine = (bv > ov) || (bv == ov && bi < oi);
            const float wv = mine ? bv : ov; const int wi = mine ? bi : oi;
            if (wv > -INFINITY) sel |= 1u << wi;
#pragma unroll
            for (int r = 0; r < 16; ++r) if (crow(r, hi) == wi) gt[r] = -INFINITY;
        }
    }

    unsigned* cnt = (unsigned*)(P.ws + WS_CTL) + 1024 + (b * 4 + h) * 32;
    unsigned* list = (unsigned*)(P.ws + WS_LIST) + (size_t)(b * 4 + h) * 32 * 8192;
    unsigned mycount = 0u;
    for (int n = 0; n < qb; ++n) { const unsigned long long bal = __builtin_amdgcn_ballot_w64(((sel >> n) & 1u) && hi == 0);
        if (lane == n) mycount = (unsigned)__builtin_popcountll(bal); }
    unsigned mybase = 0u;
    if (lane < qb && mycount != 0u) mybase = atomicAdd(cnt + lane, mycount);
    for (int n = 0; n < qb; ++n) {
        const bool mine = ((sel >> n) & 1u) && hi == 0;
        const unsigned long long bal = __builtin_amdgcn_ballot_w64(mine);
        if (bal == 0ull) continue;
        const unsigned base = (unsigned)__builtin_amdgcn_readlane((int)mybase, n);
        if (mine) { const unsigned off = (unsigned)__builtin_popcountll(bal & ((1ull << lane) - 1ull)); const unsigned rk = (unsigned)__builtin_popcount(sel & ((1u << n) - 1u));
            list[(size_t)n * 8192 + base + off] = (unsigned)pos | (rk << 16); }
    }
}
__device__ __forceinline__ void swap_pair(unsigned& a, unsigned& b) { auto rr = __builtin_amdgcn_permlane32_swap(a, b, false, false); a = rr[0]; b = rr[1]; }
struct MobaCtx { const unsigned* list; int cnt, n, ubase; };
template <int ND, int MODE>
__device__ __forceinline__ void attn_unit(int tid, const AttnPtrs& A, const Params& P, int b, int h, int qb, LAS unsigned char* lds, const MobaCtx mc) {
    constexpr int KBYTES = 64 * ND * 16 * 2;
    const int lane = tid & 63, wid = __builtin_amdgcn_readfirstlane(tid >> 6), r32 = lane & 31, hi = lane >> 5;
    const size_t rowb = (size_t)b * SEQ;
    const bool gathered = (MODE == 1) && (mc.list != nullptr);
    int ub = gathered ? mc.ubase : 0;
#pragma unroll 1
    for (;;) {
    int pos = qb * 256 + wid * 32 + r32;
    int rank = 3; bool qvalid = true;
    if (gathered) { const int e = ub + wid * 32 + r32; qvalid = e < mc.cnt; const unsigned ent = mc.list[qvalid ? e : (mc.cnt - 1)]; pos = (int)(ent & 0xffffu); rank = (int)(ent >> 16); }
    const size_t qrow = rowb + pos;
    bf16x8 qr[ND];
#pragma unroll
    for (int d0 = 0; d0 < ND; ++d0) qr[d0] = *(const bf16x8*)(A.Q + qrow * A.qp + 16 * d0 + 8 * hi);
    if (MODE == 1) {
        const float* tab = (const float*)(P.ws + WS_TABM) + (size_t)pos * 64;
#pragma unroll
        for (int d0 = 0; d0 < 2; ++d0) { const int i0 = 16 * d0 + 8 * hi; bf16x8 a = qr[d0], c2 = qr[d0 + 2];
#pragma unroll
            for (int e = 0; e < 8; ++e) { const float cs = tab[i0 + e], sn = tab[32 + i0 + e]; const float x1 = bf2f((unsigned short)a[e]), x2 = bf2f((unsigned short)c2[e]);
                a[e] = (short)f2bf(x1 * cs - x2 * sn); c2[e] = (short)f2bf(x1 * sn + x2 * cs); }
            qr[d0] = a; qr[d0 + 2] = c2; }
    }
    if (MODE == 2) {
        const float* tab = (const float*)(P.ws + WS_TABL) + (size_t)pos * 32; const int i0 = 8 * hi; bf16x8 a = qr[4], c2 = qr[5];
#pragma unroll
        for (int e = 0; e < 8; ++e) { const float cs = tab[i0 + e], sn = tab[16 + i0 + e]; const float x1 = bf2f((unsigned short)a[e]), x2 = bf2f((unsigned short)c2[e]);
            a[e] = (short)f2bf(x1 * cs - x2 * sn); c2[e] = (short)f2bf(x1 * sn + x2 * cs); }
        qr[4] = a; qr[5] = c2;
    }
    constexpr int KSLOT = ND * 2048, VSLOT = 8192;
    const bf16_t* kg = (MODE == 2) ? (const bf16_t*)(P.ws + WS_KM) + ((size_t)(b * 4 + h) * 128 * 12 * 64 + (size_t)wid * 64 + lane) * 8 : A.K + (rowb + lane) * A.kp + 8 * wid;
    const bf16_t* vg = (MODE == 2) ? (const bf16_t*)(P.ws + WS_VM) + (((size_t)(b * 4 + h) * 128 * 8 + wid) * 64 + lane) * 8 : A.V + (rowb + 16 * (wid & 3) + (lane >> 2)) * A.vp + (wid >> 2) * 32 + (lane & 3) * 8;
    const size_t kts = (MODE == 2) ? (size_t)12 * 64 * 8 : (size_t)64 * A.kp, vts = (MODE == 2) ? (size_t)8 * 64 * 8 : (size_t)64 * A.vp, k2o = (MODE == 2) ? (size_t)8 * 64 * 8 : (size_t)64;
    const bool k2 = (wid + 8) < 2 * ND;
    LAS unsigned char* Kb = lds; LAS unsigned char* Vb = lds + 4 * KSLOT;
    const unsigned kdst = (unsigned)(uintptr_t)Kb + wid * 1024, vdst = (unsigned)(uintptr_t)Vb + wid * 1024;
#define DMA_TILE(t_, slot_) do { const size_t adv_ = (size_t)(tile0 + (t_)); \
        glds16(kg + adv_ * kts, (unsigned)__builtin_amdgcn_readfirstlane(kdst + (slot_) * KSLOT)); \
        if (k2) glds16(kg + adv_ * kts + k2o, (unsigned)__builtin_amdgcn_readfirstlane(kdst + (slot_) * KSLOT + 8192)); \
        glds16(vg + adv_ * vts, (unsigned)__builtin_amdgcn_readfirstlane(vdst + (slot_) * VSLOT)); } while (0)
#define WAIT_BAR(N) asm volatile("s_waitcnt vmcnt(" #N ") lgkmcnt(0)\n\ts_barrier" ::: "memory")
    const int tile0 = (MODE == 1) ? (gathered ? 4 * mc.n : 4 * qb) : 0;
    const int NT = (MODE == 1) ? 4 : 4 * (qb + 1);
#define TI(it_) ((MODE == 0) ? (NT - 1 - (it_)) : (it_))
    float qn = 0.f; f32x2 stA = {0.f, 0.f}, stB = {0.f, 0.f}; float mseen = -INFINITY;
    if (MODE == 0) {
#pragma unroll
        for (int d0 = 0; d0 < 4; ++d0)
#pragma unroll
            for (int e = 0; e < 8; ++e) { const float v = bf2f((unsigned short)qr[d0][e]); qn += v * v; }
        qn += other_half_f(qn, hi); qn = sqrtf(qn) * 1.01f;
        const f32x2* st = (const f32x2*)(P.ws + WS_FST) + (size_t)(b * 4 + h) * 128;
        stA = st[lane]; stB = st[lane + 64];
#pragma unroll
        for (int o = 1; o < 64; o <<= 1) { const float ta = bperm_f(lane - o, stA.x), tb = bperm_f(lane - o, stB.x); if (lane >= o) { stA.x = fmaxf(stA.x, ta); stB.x = fmaxf(stB.x, tb); } }
        stB.x = fmaxf(stB.x, __builtin_bit_cast(float, __builtin_amdgcn_readlane(__builtin_bit_cast(int, stA.x), 63)));
    }
    if (!gathered || ub == mc.ubase) {
        DMA_TILE(TI(0), 0); DMA_TILE(TI(1), 1); DMA_TILE(TI(2), 2); if (MODE == 1) DMA_TILE(3, 3);
        WAIT_BAR(0);
    }
    float mrun = 0.f, lrun = 0.f; f32x16 o0 = {}, o1 = {};
    const int qrel = wid * 32 + r32;
    const int vlane = ((lane >> 4) & 1) * 32 + (lane & 3) * 8 + (4 * hi + ((lane & 15) >> 2)) * 64;
    int slot = 0;
    bool stopped = false;
#pragma unroll 1
    for (int it = 0; it < NT; ++it) {
        const int t = TI(it);
        if (MODE != 1 && it + 3 < NT) DMA_TILE(TI(it + 3), (slot + 3) & 3);
        const int trel = (MODE == 1) ? (gathered ? -1 : t) : (t - 4 * qb);
        const bool active = (64 * trel <= 32 * wid + 31);
        if (active) {
            f32x16 p0, p1;
            const LAS unsigned char* kb = Kb + slot * KSLOT + hi * 1024 + r32 * 16;
            bf16x8 kf0[ND], kf1[ND];
#pragma unroll
            for (int d0 = 0; d0 < ND; ++d0) { kf0[d0] = *(const LAS bf16x8*)(kb + d0 * 2048); kf1[d0] = *(const LAS bf16x8*)(kb + d0 * 2048 + 512); }
            { const float cinit = -mrun;
#pragma unroll
            for (int r = 0; r < 16; ++r) { p0[r] = cinit; p1[r] = cinit; } }
            __builtin_amdgcn_sched_barrier(0);
#pragma unroll
            for (int d0 = 0; d0 < ND; ++d0) {
                p0 = __builtin_amdgcn_mfma_f32_32x32x16_bf16(kf0[d0], qr[d0], p0, 0, 0, 0);
                p1 = __builtin_amdgcn_mfma_f32_32x32x16_bf16(kf1[d0], qr[d0], p1, 0, 0, 0);
            }
            __builtin_amdgcn_sched_barrier(0);
            const LAS unsigned char* vb = Vb + slot * VSLOT + vlane;
            s16x4 va0[4], va1[4], vb0[4], vb1[4];
#pragma unroll
            for (int ks = 0; ks < 4; ++ks) { va0[ks] = vtr(vb + ks * 1024); va1[ks] = vtr(vb + ks * 1024 + 512); vb0[ks] = vtr(vb + 4096 + ks * 1024); vb1[ks] = vtr(vb + 4096 + ks * 1024 + 512); }
            __builtin_amdgcn_sched_barrier(0);
            if (trel >= 0) { const int kb0 = 64 * trel + 4 * hi;
#pragma unroll
                for (int r = 0; r < 16; ++r) { const int kv = kb0 + (r & 3) + 8 * (r >> 2); if (kv > qrel) p0[r] = -INFINITY; if (kv + 32 > qrel) p1[r] = -INFINITY; } }
            float ra = fmaxf(fmaxf(p0[0], p0[1]), p1[0]), rb2 = fmaxf(fmaxf(p0[2], p0[3]), p1[1]); ra = fmaxf(fmaxf(ra, p1[2]), p1[3]);
#pragma unroll
            for (int r = 4; r < 16; r += 4) { ra = fmaxf(fmaxf(ra, p0[r]), p0[r + 1]); rb2 = fmaxf(fmaxf(rb2, p0[r + 2]), p0[r + 3]); ra = fmaxf(fmaxf(ra, p1[r]), p1[r + 1]); rb2 = fmaxf(fmaxf(rb2, p1[r + 2]), p1[r + 3]); }
            float rm = fmaxf(ra, rb2);
            rm = fmaxf(rm, other_half_f(rm, hi));
            const bool first = (it == 0);
            if (MODE == 0) mseen = fmaxf(mseen, mrun + rm);
            if (__builtin_amdgcn_ballot_w64(first ? (rm > -1e30f) : (rm > 8.f)) != 0ull) {
                const float dl = first ? ((rm > -1e30f) ? rm : 0.f) : fmaxf(rm, 0.f);
                mrun += dl;
#pragma unroll
                for (int r = 0; r < 16; ++r) { p0[r] -= dl; p1[r] -= dl; }
                const float f = __builtin_amdgcn_exp2f(-dl); lrun *= f;
#pragma unroll
                for (int r = 0; r < 16; ++r) { o0[r] *= f; o1[r] *= f; }
            }
            float ps0 = 0.f, ps1 = 0.f;
#pragma unroll
            for (int r = 0; r < 16; ++r) { p0[r] = __builtin_amdgcn_exp2f(p0[r]); p1[r] = __builtin_amdgcn_exp2f(p1[r]); ps0 += p0[r]; ps1 += p1[r]; }
            lrun += ps0 + ps1;
            u32x4 pw[4];
#pragma unroll
            for (int j = 0; j < 2; ++j) {
                pw[j] = (u32x4){cvt_pk_bf16(p0[8 * j], p0[8 * j + 1]), cvt_pk_bf16(p0[8 * j + 2], p0[8 * j + 3]), cvt_pk_bf16(p0[8 * j + 4], p0[8 * j + 5]), cvt_pk_bf16(p0[8 * j + 6], p0[8 * j + 7])};
                pw[2 + j] = (u32x4){cvt_pk_bf16(p1[8 * j], p1[8 * j + 1]), cvt_pk_bf16(p1[8 * j + 2], p1[8 * j + 3]), cvt_pk_bf16(p1[8 * j + 4], p1[8 * j + 5]), cvt_pk_bf16(p1[8 * j + 6], p1[8 * j + 7])};
            }
            __builtin_amdgcn_sched_barrier(0);
#pragma unroll
            for (int ks = 0; ks < 4; ++ks) {
                const s16x4 a0 = va0[ks], a1 = va1[ks], b0 = vb0[ks], b1 = vb1[ks];
                const bf16x8 v0f = (bf16x8){a0[0], a0[1], a0[2], a0[3], a1[0], a1[1], a1[2], a1[3]}, v1f = (bf16x8){b0[0], b0[1], b0[2], b0[3], b1[0], b1[1], b1[2], b1[3]};
                const bf16x8 pf = __builtin_bit_cast(bf16x8, pw[ks]);
                o0 = __builtin_amdgcn_mfma_f32_32x32x16_bf16(v0f, pf, o0, 0, 0, 0);
                o1 = __builtin_amdgcn_mfma_f32_32x32x16_bf16(v1f, pf, o1, 0, 0, 0);
            }
        }
        LAS int* tf = (LAS int*)(lds + 148 * 1024) + (it & 1) * 8;
        const bool chk = (MODE == 0) && (it + 1 < NT) && (t - 1 < 4 * qb);
        if (chk) { const int tn = t - 1;
            const float kpre = __builtin_bit_cast(float, __builtin_amdgcn_readlane(__builtin_bit_cast(int, tn < 64 ? stA.x : stB.x), tn & 63));
            const float gmx = __builtin_bit_cast(float, __builtin_amdgcn_readlane(__builtin_bit_cast(int, tn < 64 ? stA.y : stB.y), tn & 63));
            const bool need = (qn * kpre + gmx + 0.01f - mseen) >= -40.f;
            const unsigned long long nb = __builtin_amdgcn_ballot_w64(need);
            if (lane == 0) tf[wid] = (nb != 0ull) ? 1 : 0; }
        if (MODE != 1) {
        if (it + 3 < NT) { if (k2) WAIT_BAR(6); else WAIT_BAR(4); }
        else if (it + 2 < NT) { if (k2) WAIT_BAR(3); else WAIT_BAR(2); }
        else WAIT_BAR(0);
        }
        slot = (slot + 1) & 3;
        if (chk) { const int a0 = tf[0] | tf[1] | tf[2] | tf[3] | tf[4] | tf[5] | tf[6] | tf[7];
            if (__builtin_amdgcn_readfirstlane(a0) == 0) { stopped = true; break; } }
    }
    if (stopped) WAIT_BAR(0);
#undef TI
#undef DMA_TILE
#undef WAIT_BAR
    const float ltot = lrun + other_half_f(lrun, hi);
    const float inv = ((DBG_ZERO >> (MODE == 0 ? 0 : MODE == 1 ? 2 : 3)) & 1) ? 0.f : __builtin_amdgcn_rcpf(ltot);
    if (MODE == 1) {
        bf16_t* po = (bf16_t*)(P.ws + WS_PO) + (((qrow * 4 + h) * 4 + rank) * 64);
        if (qvalid && hi == 0) { float* pml = (float*)(P.ws + WS_PML) + ((qrow * 4 + h) * 4 + rank) * 2; pml[0] = mrun; pml[1] = ltot; }
#pragma unroll
        for (int dt = 0; dt < 2; ++dt)
#pragma unroll
            for (int k = 0; k < 2; ++k) { const f32x16& oo = dt ? o1 : o0; const int ra = 8 * k, rb = 8 * k + 4;
                unsigned ax = pk2(oo[ra] * inv, oo[ra + 1] * inv), ay = pk2(oo[ra + 2] * inv, oo[ra + 3] * inv), bx_ = pk2(oo[rb] * inv, oo[rb + 1] * inv), by = pk2(oo[rb + 2] * inv, oo[rb + 3] * inv);
                swap_pair(ax, bx_); swap_pair(ay, by);
                if (qvalid) *(u32x4*)(po + 32 * dt + 16 * k + 8 * hi) = (u32x4){ax, ay, bx_, by}; }
        if (gathered && ub + 256 < mc.cnt) { ub += 256; continue; }
        return;
    }
    const bf16_t* gp = A.G + qrow * ZP; bf16_t* op = A.O + qrow * DMODEL;
#pragma unroll
    for (int dt = 0; dt < 2; ++dt)
#pragma unroll
        for (int k = 0; k < 2; ++k) { const f32x16& oo = dt ? o1 : o0; const int ra = 8 * k, rb = 8 * k + 4;
            const u32x4 gq = *(const u32x4*)(gp + 32 * dt + 16 * k + 8 * hi);
            unsigned gx = gq.x, gy = gq.y, gz = gq.z, gw_ = gq.w;
            swap_pair(gx, gz); swap_pair(gy, gw_);
            unsigned ax = pk2(oo[ra] * inv * siluf_(bf2f(gx)), oo[ra + 1] * inv * siluf_(bf2f(gx >> 16))), ay = pk2(oo[ra + 2] * inv * siluf_(bf2f(gy)), oo[ra + 3] * inv * siluf_(bf2f(gy >> 16)));
            unsigned bx_ = pk2(oo[rb] * inv * siluf_(bf2f(gz)), oo[rb + 1] * inv * siluf_(bf2f(gz >> 16))), by = pk2(oo[rb + 2] * inv * siluf_(bf2f(gw_)), oo[rb + 3] * inv * siluf_(bf2f(gw_ >> 16)));
            swap_pair(ax, bx_); swap_pair(ay, by);
            *(u32x4*)(op + 32 * dt + 16 * k + 8 * hi) = (u32x4){ax, ay, bx_, by}; }
    return;
    }
}

__global__ void __launch_bounds__(NTHREADS, 2) fwd_megakernel(Params P) {
    extern __shared__ __attribute__((aligned(16))) unsigned char lds_raw[];
    LAS unsigned char* lds = (LAS unsigned char*)lds_raw;
    cg::grid_group grid = cg::this_grid();
    const int G = gridDim.x, bx = blockIdx.x;
    unsigned* ctl = (unsigned*)(P.ws + WS_CTL);
    const int wave_s = __builtin_amdgcn_readfirstlane((int)threadIdx.x >> 6);
    if (bx == 0) { ctl[threadIdx.x] = 0u; ctl[threadIdx.x + 512] = 0u; }
    grid.sync();
    unsigned nsync = 0;
#define GSYNC() do { ++nsync; gbar((unsigned*)(P.ws + WS_CTL), nsync, (unsigned)G, (unsigned)bx, fresh_tid()); } while (0)
    const int NGW = G * 8;
#define PHASE_PTRS() unsigned char* ws = P.ws; asm volatile("" : "+s"(ws)); bf16_t* z = (bf16_t*)(ws + WS_Z); bf16_t* xn = (bf16_t*)(ws + WS_XN); (void)z; (void)xn
#define PHASE_IDS() PHASE_PTRS(); const int tid = fresh_tid(), lane = tid & 63, wid = __builtin_amdgcn_readfirstlane(tid >> 6), gw = bx * 8 + wid; (void)lane; (void)gw

    if constexpr ((PM & 1) != 0) {
        PHASE_IDS();
        LAS float* scr = (LAS float*)lds;
        for (int it = bx; it < 2 * 1232; it += G) {
            const int l = it / 1232; int r = it % 1232;
            if (r < 896) { tconv_item(tid, P.in[2] + (size_t)l * 1024 * 3364, 3364, 0, P.in[1] + l * 1024, (bf16_t*)(ws + WS_W1T) + (size_t)l * 3584 * 1024, 1024, (r / 56) * 64, (r % 56) * 64, scr); continue; } r -= 896;
            if (r < 256) { tconv_item(tid, P.in[18] + (size_t)l * 1024 * 1024, 1024, 1, nullptr, (bf16_t*)(ws + WS_W2T) + (size_t)l * 1024 * 1024, 1024, (r / 16) * 64, (r % 16) * 64, scr); continue; } r -= 256;
            if (r < 48) { tconv_item(tid, P.in[15] + (size_t)l * 384 * 384, 384, 2, P.in[14] + l * 384, (bf16_t*)(ws + WS_WUQT) + (size_t)l * 512 * 384, 384, (r / 8) * 64, (r % 8) * 64, scr); continue; } r -= 48;
            if (r < 16) { tconv_item(tid, P.in[17] + (size_t)l * 128 * 512, 512, 3, P.in[16] + l * 128, (bf16_t*)(ws + WS_WUKVT) + (size_t)l * 512 * 128, 128, (r / 8) * 64, (r % 8) * 64, scr); continue; } r -= 16;
            tconv_item(tid, P.in[12] + (size_t)l * 256 * 256, 256, 1, nullptr, (bf16_t*)(ws + WS_GLUT) + (size_t)l * 65536, 256, (r / 4) * 64, (r % 4) * 64, scr);
        }
        float* tabM = (float*)(ws + WS_TABM); float* tabL = (float*)(ws + WS_TABL);
        for (int i = bx * NTHREADS + tid; i < SEQ * 48; i += G * NTHREADS) {
            if (i < SEQ * 32) { const int pos = i >> 5, k = i & 31; const float inv = powf(10000.f, -(float)k / 32.f); float s, c; sincos_acc((float)pos * inv, s, c); tabM[pos * 64 + k] = c; tabM[pos * 64 + 32 + k] = s; }
            else { const int j = i - SEQ * 32, pos = j >> 4, k = j & 15; const float inv = powf(10000.f, -(float)k / 16.f); float s, c; sincos_acc((float)pos * inv, s, c); tabL[pos * 32 + k] = c; tabL[pos * 32 + 16 + k] = s; }
        }
        for (int i = bx * NTHREADS + tid; i < 2 * 16 * 64; i += G * NTHREADS) {
            const int l = i >> 10, g = (i >> 6) & 15, p = i & 63; const int lg = l * 16 + g; const int gp = lg * 64 + p;
            const float ar = P.in[4][gp], ai = P.in[5][gp]; const float dt = expf(P.in[6][lg]);
            const float mag = expf(ar * dt); float s, c; sincos_acc(ai * dt, s, c); const float lr = mag * c, li = mag * s;
            double pr = 1.0, pi = 0.0; for (int k = 0; k < 32; ++k) { const double nr = pr * lr - pi * li, ni = pr * li + pi * lr; pr = nr; pi = ni; }
            float* lt = (float*)(ws + WS_S5LAM) + (size_t)gp * 4; lt[0] = lr; lt[1] = li; lt[2] = (float)pr; lt[3] = (float)pi;
            const float nr_ = lr - 1.f, ni_ = li, den = ar * ar + ai * ai; const float qr_ = (nr_ * ar + ni_ * ai) / den, qi_ = (ni_ * ar - nr_ * ai) / den;
            bf16_t* Bb = (bf16_t*)(ws + WS_S5BB) + (size_t)lg * 128 * 16; bf16_t* Cb = (bf16_t*)(ws + WS_S5CB) + (size_t)lg * 32 * 128;
            for (int ch = 0; ch < 16; ++ch) { const float br = P.in[7][(size_t)gp * 16 + ch], bi = P.in[8][(size_t)gp * 16 + ch];
                Bb[p * 16 + ch] = (bf16_t)f2bf(qr_ * br - qi_ * bi); Bb[(64 + p) * 16 + ch] = (bf16_t)f2bf(qr_ * bi + qi_ * br);
                const float cr = P.in[9][((size_t)lg * 16 + ch) * 64 + p], ci = P.in[10][((size_t)lg * 16 + ch) * 64 + p];
                Cb[ch * 128 + p] = (bf16_t)f2bf(cr); Cb[ch * 128 + 64 + p] = (bf16_t)f2bf(-ci);
                Cb[(16 + ch) * 128 + p] = 0; Cb[(16 + ch) * 128 + 64 + p] = 0; }
        }
        for (int m = gw; m < MROWS; m += 2 * NGW) rms_row2(P.in[0] + (size_t)m * DMODEL, P.in[0] + (size_t)(m + NGW) * DMODEL, xn + (size_t)m * DMODEL, xn + (size_t)(m + NGW) * DMODEL, nullptr, nullptr, nullptr, lane);
    }
    GSYNC();

#pragma unroll 1
    for (int l = 0; l < NLAYER; ++l) {
        if constexpr ((PM & 2) != 0) {
            PHASE_PTRS();
            pg8::Gemm g{xn, DMODEL, (const bf16_t*)(ws + WS_W1T) + (size_t)l * 3584 * 1024, MROWS, ZP, DMODEL};
            pg8::StaticOrder S; S.init(MROWS, ZP, G, bx);
            pg8::EpiZ E{z, ZP};
#pragma unroll 1
            for (int rep = 0; rep < DBG_REP1; ++rep)
            pg8::gemm_phase<pg8::EpiZ, true>(fresh_tid(), lds, g, S, E);
        }
        GSYNC();
        if constexpr ((PM & 4) != 0) {
            PHASE_IDS();
            if (bx == 0) { unsigned* cz = (unsigned*)(ws + WS_CTL) + 1024; cz[tid] = 0u; cz[tid + 512] = 0u; }
            if (bx < 32) {
                const int b = bx >> 2, h = bx & 3; const float fb = P.in[3][l * 4 + h];
                LAS float* sc = (LAS float*)lds;
                float lf[16]; float run = 0.f; const size_t r0 = (size_t)b * SEQ + tid * 16;
#pragma unroll
                for (int i = 0; i < 16; ++i) { const float y = bf2f(z[(r0 + i) * ZP + Z_FF + h]) + fb; const float v = fminf(y, 0.f) - log1pf(expf(-fabsf(y))); run += v; lf[i] = run; }
                float incl = run;
#pragma unroll
                for (int o = 1; o < 64; o <<= 1) { const float t = bperm_f(lane - o, incl); if (lane >= o) incl += t; }
                if (lane == 63) sc[wid] = incl;
                __syncthreads();
                float off = incl - run;
                for (int w = 0; w < wid; ++w) off += sc[w];
                { float* cum = (float*)(ws + WS_CUM) + (size_t)(b * 4 + h) * SEQ + tid * 16;
#pragma unroll
                  for (int i = 0; i < 16; i += 4) *(f32x4*)(cum + i) = (f32x4){off + lf[i], off + lf[i + 1], off + lf[i + 2], off + lf[i + 3]}; }
                __syncthreads();
            }
            for (int it = bx; it < 256; it += G) {
                const int b = it >> 5, n = it & 31;
                LAS bf16_t* ks = (LAS bf16_t*)lds;
                const int pr = tid & 15, h = pr >> 2, c = pr & 3;
#pragma unroll 1
                for (int i = 0; i < 8; ++i) {
                    const int tok = i * 32 + (tid >> 4);
                    const int pos = n * 256 + tok; const size_t row = (size_t)b * SEQ + pos;
                    bf16_t* base = z + row * ZP + Z_MK;
                    const float* tab = (const float*)(ws + WS_TABM) + (size_t)pos * 64;
                    const u32x4 a = *(const u32x4*)(base + h * 64 + 8 * c), bq = *(const u32x4*)(base + h * 64 + 32 + 8 * c);
                    const f32x4 cs0 = *(const f32x4*)(tab + 8 * c), cs1 = *(const f32x4*)(tab + 8 * c + 4), sn0 = *(const f32x4*)(tab + 32 + 8 * c), sn1 = *(const f32x4*)(tab + 32 + 8 * c + 4);
                    const unsigned aw[4] = {a.x, a.y, a.z, a.w}, bw[4] = {bq.x, bq.y, bq.z, bq.w};
                    unsigned o1[4], o2[4];
#pragma unroll
                    for (int j = 0; j < 4; ++j) { const float c0 = (j < 2) ? cs0[2 * j] : cs1[2 * j - 4], c1 = (j < 2) ? cs0[2 * j + 1] : cs1[2 * j - 3];
                        const float s0 = (j < 2) ? sn0[2 * j] : sn1[2 * j - 4], s1 = (j < 2) ? sn0[2 * j + 1] : sn1[2 * j - 3];
                        const float x1a = bf2f(aw[j]), x1b = bf2f(aw[j] >> 16), x2a = bf2f(bw[j]), x2b = bf2f(bw[j] >> 16);
                        o1[j] = pk2(x1a * c0 - x2a * s0, x1b * c1 - x2b * s1); o2[j] = pk2(x1a * s0 + x2a * c0, x1b * s1 + x2b * c1); }
                    const u32x4 w1 = {o1[0], o1[1], o1[2], o1[3]}, w2 = {o2[0], o2[1], o2[2], o2[3]};
                    *(u32x4*)(base + h * 64 + 8 * c) = w1; *(u32x4*)(base + h * 64 + 32 + 8 * c) = w2;
                    *(LAS u32x4*)(ks + tok * 264 + h * 64 + 8 * c) = w1; *(LAS u32x4*)(ks + tok * 264 + h * 64 + 32 + 8 * c) = w2;
                }
                __syncthreads();
                if (tid < 256) { float s = 0.f;
#pragma unroll 8
                    for (int t = 0; t < 256; ++t) s += bf2f(ks[t * 264 + tid]);
                    s *= (1.f / 256.f); const unsigned hh = f2bf(s); const unsigned ll = f2bf(s - bf2f(hh));
                    const size_t o = (size_t)((b * 4 + (tid >> 6)) * 32 + n) * 64 + (tid & 63);
                    ((bf16_t*)(ws + WS_KMH))[o] = (bf16_t)hh; ((bf16_t*)(ws + WS_KML))[o] = (bf16_t)ll; }
                __syncthreads();
            }
            {
                float* rsq = (float*)(ws + WS_RSQ); float* rskv = (float*)(ws + WS_RSKV); bf16_t* KMp = (bf16_t*)(ws + WS_KM);
                for (int m0 = gw; m0 < MROWS; m0 += 4 * NGW) {
                    u32x4 v4[4]; float kx1[4], kx2[4];
#pragma unroll
                    for (int u = 0; u < 4; ++u) { const int m = m0 + u * NGW; const bf16_t* zr = z + (size_t)m * ZP;
                        v4[u] = *(const u32x4*)(zr + Z_CQ + 8 * lane);
                        kx1[u] = bf2f(zr[Z_KR + (lane & 15)]); kx2[u] = bf2f(zr[Z_KR + 16 + (lane & 15)]); }
#pragma unroll
                    for (int u = 0; u < 4; ++u) { const int m = m0 + u * NGW; const u32x4 v = v4[u];
                        float ss = 0.f; { const unsigned w[4] = {v.x, v.y, v.z, v.w};
#pragma unroll
                            for (int j = 0; j < 4; ++j) { const float a = bf2f(w[j]), bq = bf2f(w[j] >> 16); ss += a * a + bq * bq; } }
                        const float sq = wave_sum(lane < 48 ? ss : 0.f, lane), skv = wave_sum(lane >= 48 ? ss : 0.f, lane);
                        if (lane == 0) { rsq[m] = 1.f / sqrtf(sq * (1.f / 384.f) + 1e-6f); rskv[m] = 1.f / sqrtf(skv * (1.f / 128.f) + 1e-6f); }
                        if (lane < 16) { const int pos = m & (SEQ - 1); const float* tab = (const float*)(ws + WS_TABL) + (size_t)pos * 32; const float cs = tab[lane], sn = tab[16 + lane];
                            const float x1 = kx1[u], x2 = kx2[u]; const bf16_t r1 = (bf16_t)f2bf(x1 * cs - x2 * sn), r2 = (bf16_t)f2bf(x1 * sn + x2 * cs);
#pragma unroll
                            for (int h = 0; h < 4; ++h) { KMp[kt_off(m, h, 8 + (lane >> 3)) + (lane & 7)] = r1; KMp[kt_off(m, h, 10 + (lane >> 3)) + (lane & 7)] = r2; } }
                    }
                }
            }
            __syncthreads();
            if (G > 64) { if (bx >= 32) for (int it = bx - 32; it < 2048; it += G - 32) s5_item<false>(fresh_tid(), P, l, it >> 8, it & 255, lds); }
            else for (int it = bx; it < 2048; it += G) s5_item<false>(fresh_tid(), P, l, it >> 8, it & 255, lds);
        }
        GSYNC();
        if constexpr ((PM & 8) != 0) {
            PHASE_IDS();
            { pg8::Gemm g{z + Z_CQ, ZP, (const bf16_t*)(ws + WS_WUQT) + (size_t)l * 512 * 384, MROWS, 512, 384};
              pg8::StaticOrder S; S.init(MROWS, 512, G, bx);
              pg8::EpiMlaQ E{(bf16_t*)(ws + WS_QM), (const float*)(ws + WS_RSQ)};
              pg8::gemm_phase<pg8::EpiMlaQ, true>(fresh_tid(), lds, g, S, E); }
            { pg8::Gemm g{z + Z_CKV, ZP, (const bf16_t*)(ws + WS_WUKVT) + (size_t)l * 512 * 128, MROWS, 512, 128};
              pg8::StaticOrder S; S.init(MROWS, 512, G, bx);
              pg8::EpiMlaKV E{(bf16_t*)(ws + WS_KM), (bf16_t*)(ws + WS_VM), (const float*)(ws + WS_RSKV)};
              pg8::gemm_phase<pg8::EpiMlaKV, true>(fresh_tid(), lds, g, S, E); }
#pragma unroll 1
            for (int it = bx; it < 512; it += G) {
                const int b = it >> 6, tile = 2 * (it & 63) + (tid >> 8), tok = tid & 63, h = (tid >> 6) & 3;
                const int t = tile * 64 + tok; const size_t row = (size_t)b * SEQ + t;
                const float gv = -((const float*)(ws + WS_CUM))[(size_t)(b * 4 + h) * SEQ + t] * LOG2E;
                const bf16_t* kp = z + row * ZP + Z_FK + h * 80; float ssq = 0.f;
#pragma unroll
                for (int c8 = 0; c8 < 8; ++c8) { const u32x4 v = *(const u32x4*)(kp + 8 * c8); const unsigned w[4] = {v.x, v.y, v.z, v.w};
#pragma unroll
                    for (int j = 0; j < 4; ++j) { const float a = bf2f(w[j]), bq = bf2f(w[j] >> 16); ssq += a * a + bq * bq; } }
                const unsigned g1 = f2bf(gv); const float r1 = gv - bf2f(g1); const unsigned g2 = f2bf(r1); const unsigned g3 = f2bf(r1 - bf2f(g2));
                *(u32x2*)(z + row * ZP + Z_FK + h * 80 + 64) = (u32x2){g1 | (g2 << 16), g3};
                { unsigned c1 = 0x3F803F80u, c2 = 0x00003F80u; asm volatile("" : "+v"(c1), "+v"(c2));
                  *(u32x2*)(z + row * ZP + Z_FQ + h * 80 + 64) = (u32x2){c1, c2}; }
#pragma unroll
                for (int o = 1; o < 64; o <<= 1) ssq = fmaxf(ssq, bperm_f(lane ^ o, ssq));
                float* st = (float*)(ws + WS_FST) + ((size_t)(b * 4 + h) * 128 + tile) * 2;
                if (lane == 0) st[0] = sqrtf(ssq) * 1.01f;
                if (lane == 63) st[1] = gv;
            }
#pragma unroll 1
            for (int it = bx; it < 1024; it += G) {
                int qb = it & 31, bh = it >> 5;
                if (G == 256) { const int k = it >> 8; qb = ((bx & 31) + 8 * k) & 31; bh = (bx >> 5) + 8 * k; }
                if (qb > 0) moba_select(fresh_tid(), P, bh >> 2, bh & 3, qb); }
            __syncthreads();
            if (bx < 128) {
                const int gid = bx * 64 + lane;
                const int b = gid >> 10, gg = (gid >> 6) & 15, p = gid & 63;
                const f32x4 lm = *(const f32x4*)((const float*)(ws + WS_S5LAM) + ((size_t)(l * 16 + gg) * 64 + p) * 4);
                const float* E = (const float*)(ws + WS_E); float* XIN = (float*)(ws + WS_XIN);
                const int c0 = wid * 32;
                float er[32], ei[32];
#pragma unroll
                for (int c = 0; c < 32; ++c) { const size_t idx = ((size_t)(b * 256 + c0 + c) * 16 + gg) * 128 + p; er[c] = E[idx]; ei[c] = E[idx + 64]; }
                float xr = 0.f, xi = 0.f;
#pragma unroll
                for (int c = 0; c < 32; ++c) { const float pr = xr, pi = xi;
                    const float nr = lm.z * xr - lm.w * xi + er[c], ni = lm.z * xi + lm.w * xr + ei[c]; xr = nr; xi = ni; er[c] = pr; ei[c] = pi; }
                LAS f32x2* ends = (LAS f32x2*)lds;
                ends[wid * 64 + lane] = (f32x2){xr, xi};
                float qr_ = lm.z, qi_ = lm.w;
#pragma unroll
                for (int k = 0; k < 5; ++k) { const float t = qr_ * qr_ - qi_ * qi_; qi_ = 2.f * qr_ * qi_; qr_ = t; }
                __syncthreads();
                float cr_ = 0.f, ci_ = 0.f;
                for (int v = 0; v < wid; ++v) { const f32x2 e = ends[v * 64 + lane]; const float t = qr_ * cr_ - qi_ * ci_ + e.x; ci_ = qr_ * ci_ + qi_ * cr_ + e.y; cr_ = t; }
                float pwr = 1.f, pwi = 0.f;
#pragma unroll
                for (int c = 0; c < 32; ++c) { const size_t idx = ((size_t)(b * 256 + c0 + c) * 16 + gg) * 128 + p;
                    XIN[idx] = er[c] + pwr * cr_ - pwi * ci_; XIN[idx + 64] = ei[c] + pwr * ci_ + pwi * cr_;
                    const float t = pwr * lm.z - pwi * lm.w; pwi = pwr * lm.w + pwi * lm.z; pwr = t; }
            } else { __syncthreads(); }
        }
        GSYNC();
        if constexpr ((PM & 16) != 0) {
            PHASE_PTRS();
            bf16_t* mix = xn;
            const int xcd = bx & 7, jcu = bx >> 3;
            const MobaCtx mc0{nullptr, 0, 0, 0};
            const int nun = (G == 256) ? 8 : (2048 + G - 1) / G;
#pragma unroll 1
            for (int i = 0; i < nun; ++i) {
                int type, bh, qb;
                if (G == 256) { const int id = 8 * i + xcd; type = id >> 5; bh = id & 31; qb = (i & 1) ? (31 - jcu) : jcu; }
                else { const int it = bx + i * G; if (it >= 2048) break; qb = 31 - it / 64; const int r = it % 64; type = r >> 5; bh = r & 31; }
                const int b = bh >> 2, h = bh & 3;
                if (type == 0) { AttnPtrs A{(const bf16_t*)(ws + WS_QM) + h * 96, 384, (const bf16_t*)(ws + WS_KM) + h * 96, 384, (const bf16_t*)(ws + WS_VM) + h * 64, 256, z + Z_LG + h * 64, mix + 768 + h * 64};
                    attn_unit<6, 2>(fresh_tid(), A, P, b, h, qb, lds, mc0); }
                else { AttnPtrs A{z + Z_FQ + h * 80, ZP, z + Z_FK + h * 80, ZP, z + Z_FV + h * 64, ZP, z + Z_FG + h * 64, mix + h * 64};
                    attn_unit<5, 0>(fresh_tid(), A, P, b, h, qb, lds, mc0); }
            }
            {
                LAS int* qslot = (LAS int*)(lds + 149 * 1024);
                const unsigned* cnts = (const unsigned*)(ws + WS_CTL) + 1024;
#pragma unroll 1
                for (;;) {
                    const int tq = fresh_tid();
                    if (tq == 0) *qslot = (int)atomicAdd((unsigned*)(ws + WS_CTL) + 8 + l, 1u);
                    __syncthreads();
                    const int it = __builtin_amdgcn_readfirstlane(*qslot);
                    __syncthreads();
                    if (it >= 2048) break;
                    if (it < 1024) {
                        const int n = it >> 5, bh = it & 31, b = bh >> 2, h = bh & 3;
                        const int cnt = (int)__builtin_amdgcn_readfirstlane((int)cnts[bh * 32 + n]);
                        AttnPtrs A{z + Z_MQ + h * 64, ZP, z + Z_MK + h * 64, ZP, z + Z_MV + h * 64, ZP, z + Z_MG + h * 64, mix + 512 + h * 64};
                        if (cnt > 0) { const MobaCtx mc{(const unsigned*)(ws + WS_LIST) + (size_t)(bh * 32 + n) * 8192, cnt, n, 0};
                            attn_unit<4, 1>(fresh_tid(), A, P, b, h, 0, lds, mc); }
                    } else {
                        const int j = it - 1024, qb = 31 - (j >> 5), bh = j & 31, b = bh >> 2, h = bh & 3;
                        AttnPtrs A{z + Z_MQ + h * 64, ZP, z + Z_MK + h * 64, ZP, z + Z_MV + h * 64, ZP, z + Z_MG + h * 64, mix + 512 + h * 64};
                        attn_unit<4, 1>(fresh_tid(), A, P, b, h, qb, lds, mc0);
                    }
                }
            }
            __syncthreads();
#pragma unroll 1
            for (int it = bx; it < 2048; it += G) s5_item<true>(fresh_tid(), P, l, it >> 8, it & 255, lds);
        }
        GSYNC();
        {
            PHASE_IDS();
            const bf16_t* PO = (const bf16_t*)(ws + WS_PO); const float* PML = (const float*)(ws + WS_PML); bf16_t* mix = xn;
            const int th = lane >> 5, h = (lane >> 3) & 3, dc = (lane & 7) * 8;
#pragma unroll 1
            for (int pp = bx; pp < MROWS / 256; pp += G)
#pragma unroll 1
            for (int jj = 0; jj < 4; ++jj) {
                float mm[4][4], ll[4][4]; u32x4 ov[4][4], gwv[4];
#pragma unroll
                for (int u = 0; u < 4; ++u) { const int m = pp * 256 + wid + 8 * (2 * (4 * jj + u) + th); const int pos = m & (SEQ - 1); const int nsel = (pos >> 8) < 3 ? (pos >> 8) : 3;
                    const size_t base = ((size_t)m * 4 + h) * 4;
#pragma unroll
                    for (int sI = 0; sI < 4; ++sI) { const bool on = (sI == 3) || (sI < nsel); const f32x2 ml = on ? *(const f32x2*)(PML + (base + sI) * 2) : (f32x2){-1e30f, 0.f};
                        mm[u][sI] = ml.x; ll[u][sI] = ml.y; ov[u][sI] = on ? *(const u32x4*)(PO + (base + sI) * 64 + dc) : (u32x4){0u, 0u, 0u, 0u}; }
                    gwv[u] = *(const u32x4*)(z + (size_t)m * ZP + Z_MG + h * 64 + dc); }
#pragma unroll
                for (int u = 0; u < 4; ++u) { const int m = pp * 256 + wid + 8 * (2 * (4 * jj + u) + th);
                    const float M4 = fmaxf(fmaxf(mm[u][0], mm[u][1]), fmaxf(mm[u][2], mm[u][3]));
                    float wsum = 0.f, acc[8] = {0.f, 0.f, 0.f, 0.f, 0.f, 0.f, 0.f, 0.f};
#pragma unroll
                    for (int sI = 0; sI < 4; ++sI) { const float w = ll[u][sI] * __builtin_amdgcn_exp2f(mm[u][sI] - M4); wsum += w;
                        const unsigned q4[4] = {ov[u][sI].x, ov[u][sI].y, ov[u][sI].z, ov[u][sI].w};
#pragma unroll
                        for (int e = 0; e < 4; ++e) { acc[2 * e] += w * bf2f(q4[e]); acc[2 * e + 1] += w * bf2f(q4[e] >> 16); } }
                    const float inv = __builtin_amdgcn_rcpf(wsum);
                    const unsigned g4[4] = {gwv[u].x, gwv[u].y, gwv[u].z, gwv[u].w}; unsigned o4[4];
#pragma unroll
                    for (int e = 0; e < 4; ++e) o4[e] = pk2(acc[2 * e] * inv * siluf_(bf2f(g4[e])), acc[2 * e + 1] * inv * siluf_(bf2f(g4[e] >> 16)));
                    *(u32x4*)(mix + (size_t)m * DMODEL + 512 + h * 64 + dc) = (u32x4){o4[0], o4[1], o4[2], o4[3]}; }
            }
            asm volatile("s_waitcnt vmcnt(0)" ::: "memory");
            __syncthreads();
            __builtin_amdgcn_fence(__ATOMIC_ACQUIRE, "agent");
        }
        {
            PHASE_IDS();
            pg8::Gemm g{xn, DMODEL, (const bf16_t*)(ws + WS_W2T) + (size_t)l * 1024 * 1024, MROWS, DMODEL, DMODEL};
            pg8::StaticOrder S; S.init(MROWS, DMODEL, G, bx, true);
            bf16_t* dbuf = (bf16_t*)(ws + WS_QM);
            pg8::EpiZ E{dbuf, DMODEL};
            pg8::gemm_phase<pg8::EpiZ, true>(tid, lds, g, S, E);
            asm volatile("s_waitcnt vmcnt(0)" ::: "memory");
            __syncthreads();
            __builtin_amdgcn_fence(__ATOMIC_ACQUIRE, "agent");
            const float* basep = (l == 0) ? P.in[0] : (const float*)P.out;
#pragma unroll 1
            for (int p = bx; p < MROWS / 256; p += G)
#pragma unroll 1
                for (int r = wid; r < 256; r += 16) { const size_t ra = ((size_t)p * 256 + r) * DMODEL, rb = ra + 8 * DMODEL;
                    if (l + 1 < NLAYER) res_rms_row2(basep + ra, basep + rb, dbuf + ra, dbuf + rb, P.out + ra, P.out + rb, xn + ra, xn + rb, nullptr, nullptr, nullptr, lane);
                    else res_rms_row2(basep + ra, basep + rb, dbuf + ra, dbuf + rb, nullptr, nullptr, nullptr, nullptr, P.out + ra, P.out + rb, P.in[19], lane); }
        }
        if (l + 1 < NLAYER) GSYNC();
    }
}

extern "C" void kernel_launch(void* const* d_in, const int* in_sizes, int n_in, void* d_out, int out_size, void* d_ws, size_t ws_size, hipStream_t stream) {
    static int grid_blocks = 0;
    if (grid_blocks == 0) {
        if (n_in != 20 || ws_size < WS_END) { fprintf(stderr, "kernel_launch: unexpected inputs (n_in %d, ws %zu)\n", n_in, ws_size); grid_blocks = -1; return; }
        int dev = 0, cus = 0, per_cu = 0;
        hipGetDevice(&dev);
        hipDeviceGetAttribute(&cus, hipDeviceAttributeMultiprocessorCount, dev);
        if (hipFuncSetAttribute((const void*)fwd_megakernel, hipFuncAttributeMaxDynamicSharedMemorySize, LDS_BYTES) != hipSuccess) { fprintf(stderr, "kernel_launch: hipFuncSetAttribute failed\n"); grid_blocks = -1; return; }
        if (hipOccupancyMaxActiveBlocksPerMultiprocessor(&per_cu, (const void*)fwd_megakernel, NTHREADS, LDS_BYTES) != hipSuccess || per_cu < 1) { fprintf(stderr, "kernel_launch: occupancy query says %d\n", per_cu); per_cu = 1; }
        (void)hipGetLastError();
        grid_blocks = cus * (per_cu > 1 ? 1 : per_cu);
    }
    if (grid_blocks < 0) return;
    Params p{};
    for (int i = 0; i < 20; ++i) p.in[i] = (const float*)d_in[i];
    p.out = (float*)d_out; p.ws = (unsigned char*)d_ws;
    void* args[] = {&p};
    hipError_t e = hipLaunchCooperativeKernel((const void*)fwd_megakernel, dim3(grid_blocks), dim3(NTHREADS), args, LDS_BYTES, stream);
    if (e != hipSuccess) fprintf(stderr, "cooperative launch failed: %s (grid %d)\n", hipGetErrorString(e), grid_blocks);
}
```
